# Optimizing an MI355X kernel written in HIP

```python
import jax, jax.numpy as jnp
from jax import lax
import numpy as np

D_MODEL = 1024
BATCH = 16
SEQ = 4096
DEPTH = 4

N_META = 16
NORM_EPS = 1e-6
N_BRANCHES = 4
MASK_VALUE = -1e30

A_HEADS = 4
A_HEAD_DIM = 64
A_WIDTH = A_HEADS * A_HEAD_DIM
A_DECAY_LORA = 64
A_ICL_LORA = 64
A_VRES_LORA = 32
A_GATE_LORA = 128
A_GN_EPS = 64e-5
A_COLS = 3 * A_WIDTH + A_DECAY_LORA + A_ICL_LORA + A_GATE_LORA

B_GROUPS = 4
B_GROUP_DIM = 64
B_WIDTH = B_GROUPS * B_GROUP_DIM
B_WINDOWS = (2, 4, 8, 16)

C_HEADS = 8
C_KV_HEADS = 2
C_GROUP = C_HEADS // C_KV_HEADS
C_HEAD_DIM = 64
C_WIDTH = C_HEADS * C_HEAD_DIM
C_KV_WIDTH = C_KV_HEADS * C_HEAD_DIM
C_COLS = C_WIDTH + 2 * C_KV_WIDTH
WINDOW = 128
C_BLOCK = 128

D_HEADS = 4
D_KEY_DIM = 64
D_VAL_DIM = 64
D_WIDTH = D_HEADS * D_KEY_DIM
D_OUT = D_HEADS * D_VAL_DIM
D_COLS = 2 * D_WIDTH + 2 * D_OUT
D_CHUNK = 64

D_FF = ((8 * D_MODEL + 3 * 256 - 1) // (3 * 256)) * 256

GATE_COLS = N_BRANCHES * D_MODEL
OFF_A = GATE_COLS
OFF_B = OFF_A + A_COLS
OFF_C = OFF_B + B_WIDTH
OFF_D = OFF_C + C_COLS
IN_COLS = OFF_D + D_COLS

ROW_B = A_WIDTH
ROW_C = ROW_B + B_WIDTH
ROW_D = ROW_C + C_WIDTH
MIX_WIDTH = ROW_D + D_OUT

kernel_name = "hybrid_rwkv7_pool_swa_hgrn2_gated"

F32 = jnp.float32


def rms_norm(x, g):
    xf = x.astype(F32)
    y = xf * lax.rsqrt(jnp.mean(xf * xf, axis=-1, keepdims=True) + NORM_EPS)
    return (y * g.astype(F32)).astype(x.dtype)


def token_shift(u):
    return jnp.pad(u, ((0, 0), (1, 0), (0, 0)))[:, :-1]


def split_heads(t, n):
    return t.reshape(t.shape[:-1] + (-1, n))


def alibi_slopes(n):
    return jnp.asarray([2.0 ** (-8.0 * (i + 1) / n) for i in range(n)], dtype=F32)


def rwkv7_branch(u, mu, w_up, w0, a_up, a0, g_up, k_k, k_a, r_k, ln_w, ln_b,
                 v_first, vres_down, vres_up, vres0):
    dt = u.dtype
    bsz, L, _ = u.shape
    u = u + (token_shift(u) - u) * mu
    r = u[..., 0:A_WIDTH]
    k = u[..., A_WIDTH:2 * A_WIDTH]
    v = u[..., 2 * A_WIDTH:3 * A_WIDTH]
    o1 = 3 * A_WIDTH
    o2 = o1 + A_DECAY_LORA
    o3 = o2 + A_ICL_LORA
    wd = u[..., o1:o2]
    ad = u[..., o2:o3]
    gd = u[..., o3:o3 + A_GATE_LORA]
    if vres_down is not None:
        v = v + (v_first - v) * jax.nn.sigmoid(vres0 + (v @ vres_down) @ vres_up)
    w_log = -jax.nn.softplus(-(w0 + jnp.tanh(wd) @ w_up)) - 0.5
    decay = jnp.exp(-jnp.exp(w_log.astype(F32)))
    a = jax.nn.sigmoid(a0 + ad @ a_up)
    g = jax.nn.sigmoid(gd) @ g_up
    kk = split_heads((k * k_k).astype(F32), A_HEAD_DIM)
    kk = kk / jnp.maximum(jnp.sqrt(jnp.sum(kk * kk, axis=-1, keepdims=True)), 1e-12)
    k = k * (1 + (a - 1) * k_a)

    def tm(t):
        return jnp.moveaxis(split_heads(t.astype(F32), A_HEAD_DIM), 1, 0)

    xs = (tm(r), tm(decay), tm(k), tm(v), jnp.moveaxis(kk, 1, 0), tm(a))

    def step(S, inp):
        r_t, w_t, k_t, v_t, kk_t, a_t = inp
        sa = jnp.einsum('bhvk,bhk->bhv', S, -kk_t)
        S = (S * w_t[:, :, None, :] + sa[..., None] * (kk_t * a_t)[:, :, None, :]
             + v_t[..., None] * k_t[:, :, None, :])
        return S, jnp.einsum('bhvk,bhk->bhv', S, r_t)

    S0 = jnp.zeros((bsz, A_HEADS, A_HEAD_DIM, A_HEAD_DIM), F32)
    _, o = lax.scan(step, S0, xs)
    o = jnp.moveaxis(o, 0, 1)
    mean = jnp.mean(o, axis=-1, keepdims=True)
    var = jnp.mean(jnp.square(o - mean), axis=-1, keepdims=True)
    o = ((o - mean) * lax.rsqrt(var + A_GN_EPS)).reshape(bsz, L, A_WIDTH)
    o = o * ln_w.astype(F32) + ln_b.astype(F32)
    bonus = (jnp.sum(split_heads((r * k * r_k).astype(F32), A_HEAD_DIM), axis=-1, keepdims=True)
             * split_heads(v.astype(F32), A_HEAD_DIM)).reshape(bsz, L, A_WIDTH)
    return ((o + bonus) * g.astype(F32)).astype(dt), v


def pool_branch(u, mix, scale):
    dt = u.dtype
    bsz, L, _ = u.shape
    ug = u.reshape(bsz, L, B_GROUPS, B_GROUP_DIM).astype(F32)
    cs = jnp.cumsum(ug, axis=1)
    wmax = max(B_WINDOWS)
    cs_pad = jnp.pad(cs, ((0, 0), (wmax, 0), (0, 0), (0, 0)))
    t = jnp.arange(L)
    outs = []
    for gi, w in enumerate(B_WINDOWS):
        prev = cs_pad[:, wmax - w:wmax - w + L, gi]
        cnt = jnp.minimum(t + 1, w).astype(F32)[None, :, None]
        outs.append((cs[:, :, gi] - prev) / cnt)
    pooled = jnp.stack(outs, axis=2) - ug
    y = jnp.einsum('blgc,gcd->blgd', pooled, mix.astype(F32)).reshape(bsz, L, B_WIDTH)
    return (y * scale.astype(F32)).astype(dt)


def swa_branch(u, sinks, slopes):
    dt = u.dtype
    bsz, L, _ = u.shape
    pad = (-L) % C_BLOCK
    Lp = L + pad
    nb = Lp // C_BLOCK

    def blocks(t, nh):
        t = jnp.pad(t.astype(F32), ((0, 0), (pad, 0), (0, 0)))
        return t.reshape(bsz, nb, C_BLOCK, nh, C_HEAD_DIM)

    q = blocks(u[..., :C_WIDTH], C_HEADS).reshape(bsz, nb, C_BLOCK, C_KV_HEADS, C_GROUP, C_HEAD_DIM)
    k = blocks(u[..., C_WIDTH:C_WIDTH + C_KV_WIDTH], C_KV_HEADS)
    v = blocks(u[..., C_WIDTH + C_KV_WIDTH:], C_KV_HEADS)

    def with_prev(t):
        prev = jnp.pad(t, ((0, 0), (1, 0), (0, 0), (0, 0), (0, 0)))[:, :-1]
        return jnp.concatenate([prev, t], axis=2)

    kw, vw = with_prev(k), with_prev(v)
    scores = jnp.einsum('bnqhgd,bnshd->bhgnqs', q, kw) * (C_HEAD_DIM ** -0.5)
    qi = np.arange(C_BLOCK)[:, None]
    si = np.arange(2 * C_BLOCK)[None, :]
    dist = C_BLOCK + qi - si
    band = (dist >= 0) & (dist < WINDOW)
    key_pos = np.arange(nb)[:, None] * C_BLOCK + np.arange(2 * C_BLOCK)[None, :] - C_BLOCK
    mask = band[None] & (key_pos >= pad)[:, None, :]
    sl = slopes.reshape(C_KV_HEADS, C_GROUP)
    logits = scores - sl[:, :, None, None, None] * jnp.asarray(dist, F32)
    logits = jnp.where(mask, logits, MASK_VALUE)
    sink = sinks.astype(F32).reshape(C_KV_HEADS, C_GROUP)[None, :, :, None, None, None]
    m = jnp.maximum(jnp.max(logits, axis=-1, keepdims=True), sink)
    p = jnp.exp(logits - m)
    denom = jnp.sum(p, axis=-1, keepdims=True) + jnp.exp(sink - m)
    out = jnp.einsum('bhgnqs,bnshd->bnqhgd', p / denom, vw)
    return out.reshape(bsz, Lp, C_WIDTH)[:, pad:].astype(dt)


def hgrn2_branch(u, lb, norm_g):
    dt = u.dtype
    bsz, L, _ = u.shape
    q = jax.nn.silu(u[..., :D_WIDTH].astype(F32))
    fpre = u[..., D_WIDTH:2 * D_WIDTH].astype(F32)
    i_in = u[..., 2 * D_WIDTH:2 * D_WIDTH + D_OUT].astype(F32)
    g = u[..., 2 * D_WIDTH + D_OUT:].astype(F32)
    f = lb + (1 - lb) * jax.nn.sigmoid(fpre)
    logf = jnp.log(jnp.maximum(f, 1e-30))
    k = (1 - lb) * jax.nn.sigmoid(-fpre)
    pad = (-L) % D_CHUNK
    n = (L + pad) // D_CHUNK

    def chunks(t, d):
        t = jnp.pad(t, ((0, 0), (pad, 0), (0, 0)))
        return t.reshape(bsz, n, D_CHUNK, D_HEADS, d).transpose(1, 0, 3, 2, 4)

    qc, kc, vc = chunks(q, D_KEY_DIM), chunks(k, D_KEY_DIM), chunks(i_in, D_VAL_DIM)
    bc = jnp.cumsum(chunks(logf, D_KEY_DIM), axis=3)
    causal = jnp.asarray(np.tril(np.ones((D_CHUNK, D_CHUNK), dtype=bool)))

    def chunk_step(S, inp):
        q_, k_, v_, b_ = inp
        o_inter = jnp.einsum('bhtc,bhcv->bhtv', q_ * jnp.exp(b_), S)
        diff = b_[:, :, :, None, :] - b_[:, :, None, :, :]
        dec = jnp.where(causal[:, :, None], jnp.exp(jnp.minimum(diff, 0.0)), 0.0)
        A = jnp.einsum('bhtc,bhsc,bhtsc->bhts', q_, k_, dec)
        o = o_inter + jnp.einsum('bhts,bhsv->bhtv', A, v_)
        b_last = b_[:, :, -1:, :]
        S = S * jnp.exp(b_last)[:, :, 0, :, None] + jnp.einsum(
            'bhsc,bhsv->bhcv', k_ * jnp.exp(b_last - b_), v_)
        return S, o

    S0 = jnp.zeros((bsz, D_HEADS, D_KEY_DIM, D_VAL_DIM), F32)
    _, o = lax.scan(chunk_step, S0, (qc, kc, vc, bc))
    o = o.transpose(1, 0, 3, 2, 4).reshape(bsz, n * D_CHUNK, D_HEADS, D_VAL_DIM)[:, pad:]
    o = o * lax.rsqrt(jnp.mean(o * o, axis=-1, keepdims=True) + NORM_EPS)
    o = o.reshape(bsz, L, D_OUT) * norm_g.astype(F32) * jax.nn.silu(g)
    return o.astype(dt)


def setup_inputs(seed: int = 0) -> dict:
    key = jax.random.key(seed)
    ks = jax.random.split(key, 32)

    def nrm(k, shape, scale):
        return jax.random.normal(k, shape, F32) * scale

    row_scale = jnp.concatenate([
        jnp.full((A_WIDTH,), A_WIDTH ** -0.5, F32), jnp.full((B_WIDTH,), B_WIDTH ** -0.5, F32),
        jnp.full((C_WIDTH,), C_WIDTH ** -0.5, F32), jnp.full((D_OUT,), D_OUT ** -0.5, F32)])
    return {
        "x": nrm(ks[0], (BATCH, SEQ, D_MODEL), 1.0),
        "meta": nrm(ks[1], (N_META, D_MODEL), 1.0),
        "norm_mix": 1.0 + nrm(ks[2], (DEPTH, D_MODEL), 0.1),
        "norm_ffn": 1.0 + nrm(ks[3], (DEPTH, D_MODEL), 0.1),
        "norm_final": 1.0 + nrm(ks[4], (D_MODEL,), 0.1),
        "w_in": nrm(ks[5], (DEPTH, D_MODEL, IN_COLS), D_MODEL ** -0.5),
        "w_branch": nrm(ks[6], (DEPTH, MIX_WIDTH, D_MODEL), 1.0) * row_scale[None, :, None],
        "w_out": nrm(ks[7], (DEPTH, D_MODEL, D_MODEL), D_MODEL ** -0.5),
        "a_mu": jax.random.uniform(ks[8], (DEPTH, A_COLS), F32),
        "a_w_up": nrm(ks[9], (DEPTH, A_DECAY_LORA, A_WIDTH), A_DECAY_LORA ** -0.5),
        "a_w0": -1.0 + nrm(ks[10], (DEPTH, A_WIDTH), 0.5),
        "a_a_up": nrm(ks[11], (DEPTH, A_ICL_LORA, A_WIDTH), A_ICL_LORA ** -0.5),
        "a_a0": nrm(ks[12], (DEPTH, A_WIDTH), 0.1),
        "a_g_up": nrm(ks[13], (DEPTH, A_GATE_LORA, A_WIDTH), A_GATE_LORA ** -0.5),
        "a_kk": 0.85 + nrm(ks[14], (DEPTH, A_WIDTH), 0.1),
        "a_ka": 1.0 + nrm(ks[15], (DEPTH, A_WIDTH), 0.1),
        "a_rk": nrm(ks[16], (DEPTH, A_WIDTH), 0.1),
        "a_ln_w": 1.0 + nrm(ks[17], (DEPTH, A_WIDTH), 0.1),
        "a_ln_b": nrm(ks[18], (DEPTH, A_WIDTH), 0.01),
        "a_vres_down": nrm(ks[19], (DEPTH - 1, A_WIDTH, A_VRES_LORA), A_WIDTH ** -0.5),
        "a_vres_up": nrm(ks[20], (DEPTH - 1, A_VRES_LORA, A_WIDTH), A_VRES_LORA ** -0.5),
        "a_vres0": nrm(ks[21], (DEPTH - 1, A_WIDTH), 0.1),
        "b_mix": nrm(ks[22], (DEPTH, B_GROUPS, B_GROUP_DIM, B_GROUP_DIM), B_GROUP_DIM ** -0.5),
        "b_scale": 1.0 + nrm(ks[23], (DEPTH, B_WIDTH), 0.1),
        "c_sinks": nrm(ks[24], (DEPTH, C_HEADS), 0.5),
        "d_lower_bounds": nrm(ks[25], (DEPTH, D_WIDTH), 0.1),
        "d_norm": 1.0 + nrm(ks[26], (DEPTH, D_OUT), 0.1),
        "w_ffn_up": nrm(ks[27], (DEPTH, D_MODEL, 2 * D_FF), D_MODEL ** -0.5),
        "w_ffn_down": nrm(ks[28], (DEPTH, D_FF, D_MODEL), D_FF ** -0.5),
    }


def reference(x, meta, norm_mix, norm_ffn, norm_final, w_in, w_branch, w_out,
              a_mu, a_w_up, a_w0, a_a_up, a_a0, a_g_up, a_kk, a_ka, a_rk, a_ln_w, a_ln_b,
              a_vres_down, a_vres_up, a_vres0, b_mix, b_scale, c_sinks,
              d_lower_bounds, d_norm, w_ffn_up, w_ffn_down):
    bsz = x.shape[0]
    h = jnp.concatenate(
        [jnp.broadcast_to(meta.astype(x.dtype)[None], (bsz, N_META, D_MODEL)), x], axis=1)
    L = h.shape[1]
    lb_w = jax.nn.softmax(d_lower_bounds.astype(F32), axis=0)
    lb_table = jnp.cumsum(lb_w, axis=0) - lb_w[0]
    slopes = alibi_slopes(C_HEADS)
    v_first = None
    for l in range(DEPTH):
        z = rms_norm(h, norm_mix[l])
        proj = z @ w_in[l]
        gates = jax.nn.sigmoid(proj[..., :GATE_COLS]).reshape(bsz, L, N_BRANCHES, D_MODEL)
        u_a = proj[..., OFF_A:OFF_B]
        if l == 0:
            y_a, v_first = rwkv7_branch(u_a, a_mu[l], a_w_up[l], a_w0[l], a_a_up[l], a_a0[l],
                                        a_g_up[l], a_kk[l], a_ka[l], a_rk[l], a_ln_w[l], a_ln_b[l],
                                        None, None, None, None)
        else:
            y_a, _ = rwkv7_branch(u_a, a_mu[l], a_w_up[l], a_w0[l], a_a_up[l], a_a0[l],
                                  a_g_up[l], a_kk[l], a_ka[l], a_rk[l], a_ln_w[l], a_ln_b[l],
                                  v_first, a_vres_down[l - 1], a_vres_up[l - 1], a_vres0[l - 1])
        y_b = pool_branch(proj[..., OFF_B:OFF_C], b_mix[l], b_scale[l])
        y_c = swa_branch(proj[..., OFF_C:OFF_D], c_sinks[l], slopes)
        y_d = hgrn2_branch(proj[..., OFF_D:IN_COLS], lb_table[l], d_norm[l])
        wb = w_branch[l]
        merged = (gates[:, :, 0] * (y_a @ wb[:ROW_B])
                  + gates[:, :, 1] * (y_b @ wb[ROW_B:ROW_C])
                  + gates[:, :, 2] * (y_c @ wb[ROW_C:ROW_D])
                  + gates[:, :, 3] * (y_d @ wb[ROW_D:]))
        h = h + merged @ w_out[l]
        z = rms_norm(h, norm_ffn[l])
        gu = z @ w_ffn_up[l]
        h = h + (jax.nn.silu(gu[..., :D_FF]) * gu[..., D_FF:]) @ w_ffn_down[l]
    return rms_norm(h, norm_final)[:, N_META:]
```

```cpp
#include <hip/hip_runtime.h>
#include <hip/hip_cooperative_groups.h>
#include <cstdio>
#include <cstdint>
namespace cg = cooperative_groups;

#ifndef SINGLE_LAUNCH
#define SINGLE_LAUNCH 1
#endif

namespace pg8 {
#define PG8_LAS __attribute__((address_space(3)))
typedef unsigned short bf16_t;
typedef short bf16x8 __attribute__((ext_vector_type(8)));
typedef float f32x4 __attribute__((ext_vector_type(4)));
typedef unsigned u32x4 __attribute__((ext_vector_type(4)));
constexpr int BM = 256, BK = 64, HALF = 128, HTB = HALF * BK * 2  , STAGE_BYTES = 8 * HTB, NXCD = 8, WGM = 8;

__host__ __device__ __forceinline__ int lds_byte(int r, int c) { const int st = (r >> 4) * 2 + (c >> 5), rr = r & 15, cc = c & 31, ob = rr * 64 + cc * 2; return st * 1024 + (ob ^ (((ob >> 9) & 1) << 5)); }
__host__ __device__ __forceinline__ void stage_rc(int b, int& R, int& C) { const int st = b / 1024, sb = b % 1024, swz = sb ^ (((sb >> 9) & 1) << 5); R = (st >> 1) * 16 + swz / 64; C = (st & 1) * 32 + (swz % 64) / 2; }
__host__ __device__ __forceinline__ int perm32(int rho) { const int n = rho >> 4, i = rho & 15; return 8 * (i >> 2) + 4 * n + (i & 3); }

struct Unit { int pm, pn; };
struct Gemm { const bf16_t* A; const bf16_t* Bt; int M, N, K; };

struct StaticOrder {
    int nM, nN, nwg, G, c;
    __host__ __device__ void init(int M, int N, int G_, int c_) { nM = M / BM; nN = N / BM; nwg = nM * nN; G = G_; c = c_; }
    __host__ __device__ bool next(int i, Unit& u) const {
        const long L = (long)i * G + c; if (L >= nwg) return false;
        int wgid = (int)L; { const int q = nwg / NXCD, r = nwg % NXCD, xcd = wgid % NXCD, off = wgid / NXCD; wgid = (xcd < r ? xcd * (q + 1) : r * (q + 1) + (xcd - r) * q) + off; }
        const int nig = WGM * nN, gid = wgid / nig, fm = gid * WGM, gsz = (nM - fm) < WGM ? (nM - fm) : WGM;
        u.pm = fm + ((wgid % nig) % gsz); u.pn = (wgid % nig) / gsz; return true;
    }
    __device__ __forceinline__ void a_ready(const Unit&) const {}
    __device__ __forceinline__ void done(const Unit&) const {}
};
__device__ __forceinline__ unsigned cvt_pk_bf16(float lo, float hi) { unsigned r; asm volatile("v_cvt_pk_bf16_f32 %0, %1, %2" : "=v"(r) : "v"(lo), "v"(hi)); return r; }
typedef float f32x2 __attribute__((ext_vector_type(2)));
typedef unsigned u32x2 __attribute__((ext_vector_type(2)));
__device__ __forceinline__ float sigm_f(float x) { return __builtin_amdgcn_rcpf(1.0f + __expf(-x)); }
__device__ __forceinline__ float ebflo(unsigned w) { return __uint_as_float(w << 16); }
__device__ __forceinline__ float ebfhi(unsigned w) { return __uint_as_float(w & 0xffff0000u); }

struct EpiStore {
    static constexpr bool PERM = true, AFTER_DRAIN = false;
    bf16_t* O; int ldc;
    __device__ __forceinline__ void operator()(const f32x4 (&acc)[2][2][4][2], const Unit& u, int wr, int wc, int fr, int fq) const {
        const int row0 = u.pm * BM + wr * 64 + fr, col0 = u.pn * BM + wc * 32 + 8 * fq;
#pragma unroll
        for (int ai = 0; ai < 2; ++ai)
#pragma unroll
            for (int m = 0; m < 4; ++m) { bf16_t* rowp = O + (size_t)(row0 + ai * HALF + m * 16) * ldc + col0;
#pragma unroll
                for (int bj = 0; bj < 2; ++bj) { const f32x4 v0 = acc[ai][bj][m][0], v1 = acc[ai][bj][m][1];
                    u32x4 w; w.x = cvt_pk_bf16(v0[0], v0[1]); w.y = cvt_pk_bf16(v0[2], v0[3]); w.z = cvt_pk_bf16(v1[0], v1[1]); w.w = cvt_pk_bf16(v1[2], v1[3]);
                    *(u32x4*)(rowp + bj * HALF) = w; } }
    }
};
struct EpiResid {
    static constexpr bool PERM = false, AFTER_DRAIN = false;
    bf16_t* H;
    __device__ __forceinline__ void operator()(const f32x4 (&acc)[2][2][4][2], const Unit& u, int wr, int wc, int fr, int fq) const {
        const int row0 = u.pm * BM + wr * 64 + fr, col0 = u.pn * BM + wc * 32 + 4 * fq;
#pragma unroll
        for (int ai = 0; ai < 2; ++ai)
#pragma unroll
            for (int m = 0; m < 4; ++m) { bf16_t* rowp = H + (size_t)(row0 + ai * HALF + m * 16) * 1024 + col0;
#pragma unroll
                for (int bj = 0; bj < 2; ++bj)
#pragma unroll
                    for (int n = 0; n < 2; ++n) { u32x2* q = (u32x2*)(rowp + bj * HALF + n * 16); const u32x2 hv = *q; const f32x4 a = acc[ai][bj][m][n];
                        u32x2 w; w.x = cvt_pk_bf16(ebflo(hv.x) + a[0], ebfhi(hv.x) + a[1]); w.y = cvt_pk_bf16(ebflo(hv.y) + a[2], ebfhi(hv.y) + a[3]); *q = w; } }
    }
};
struct EpiSwiglu {
    static constexpr bool PERM = false, AFTER_DRAIN = false;
    bf16_t* ACT;
    __device__ __forceinline__ void operator()(const f32x4 (&acc)[2][2][4][2], const Unit& u, int wr, int wc, int fr, int fq) const {
        const int row0 = u.pm * BM + wr * 64 + fr, col0 = u.pn * 128 + wc * 16 + 4 * fq;
#pragma unroll
        for (int ai = 0; ai < 2; ++ai)
#pragma unroll
            for (int m = 0; m < 4; ++m) { bf16_t* rowp = ACT + (size_t)(row0 + ai * HALF + m * 16) * 2816 + col0;
#pragma unroll
                for (int bj = 0; bj < 2; ++bj) { const f32x4 g = acc[ai][bj][m][0], uu = acc[ai][bj][m][1];
                    u32x2 w; w.x = cvt_pk_bf16(g[0] * sigm_f(g[0]) * uu[0], g[1] * sigm_f(g[1]) * uu[1]); w.y = cvt_pk_bf16(g[2] * sigm_f(g[2]) * uu[2], g[3] * sigm_f(g[3]) * uu[3]);
                    *(u32x2*)(rowp + bj * 64) = w; } }
    }
};

struct EpiGate4 {
    static constexpr bool PERM = false, AFTER_DRAIN = false;
    const bf16_t* T0; const bf16_t* T1; const bf16_t* T2; const bf16_t* T3; bf16_t* MRG;
    __device__ __forceinline__ void operator()(const f32x4 (&acc)[2][2][4][2], const Unit& u, int wr, int wc, int fr, int fq) const {
        const int row0 = u.pm * BM + wr * 64 + fr, j0 = u.pn * 64 + wc * 16 + 4 * fq;
#pragma unroll
        for (int ai = 0; ai < 2; ++ai)
#pragma unroll
            for (int m = 0; m < 4; ++m) { const size_t off = (size_t)(row0 + ai * HALF + m * 16) * 1024 + j0;
                const u32x2 t0 = *(const u32x2*)(T0 + off), t1 = *(const u32x2*)(T1 + off), t2 = *(const u32x2*)(T2 + off), t3 = *(const u32x2*)(T3 + off);
                const f32x4 g0 = acc[ai][0][m][0], g1 = acc[ai][0][m][1], g2 = acc[ai][1][m][0], g3 = acc[ai][1][m][1];
                const float r0 = (sigm_f(g0[0]) * ebflo(t0.x) + sigm_f(g1[0]) * ebflo(t1.x)) + (sigm_f(g2[0]) * ebflo(t2.x) + sigm_f(g3[0]) * ebflo(t3.x));
                const float r1 = (sigm_f(g0[1]) * ebfhi(t0.x) + sigm_f(g1[1]) * ebfhi(t1.x)) + (sigm_f(g2[1]) * ebfhi(t2.x) + sigm_f(g3[1]) * ebfhi(t3.x));
                const float r2 = (sigm_f(g0[2]) * ebflo(t0.y) + sigm_f(g1[2]) * ebflo(t1.y)) + (sigm_f(g2[2]) * ebflo(t2.y) + sigm_f(g3[2]) * ebflo(t3.y));
                const float r3 = (sigm_f(g0[3]) * ebfhi(t0.y) + sigm_f(g1[3]) * ebfhi(t1.y)) + (sigm_f(g2[3]) * ebfhi(t2.y) + sigm_f(g3[3]) * ebfhi(t3.y));
                u32x2 w; w.x = cvt_pk_bf16(r0, r1); w.y = cvt_pk_bf16(r2, r3);
                *(u32x2*)(MRG + off) = w; }
    }
};

struct EpiAny {
    static constexpr bool AFTER_DRAIN = false;
    int kind; bool perm; EpiStore st; EpiGate4 gt; EpiResid rs; EpiSwiglu sw;
    __device__ __forceinline__ void operator()(const f32x4 (&acc)[2][2][4][2], const Unit& u, int wr, int wc, int fr, int fq) const {
        if (kind == 0) st(acc, u, wr, wc, fr, fq); else if (kind == 1) gt(acc, u, wr, wc, fr, fq); else if (kind == 2) rs(acc, u, wr, wc, fr, fq); else sw(acc, u, wr, wc, fr, fq);
    }
};

template <class Epi, class Sched, bool ALIGN_EPI = false, bool SP2 = false>
__device__ __forceinline__ void gemm_phase(PG8_LAS unsigned char* lds, const Gemm g, const Sched& S, const Epi& E) {
    int tid = threadIdx.x; asm volatile("" : "+v"(tid));
    const int wid = __builtin_amdgcn_readfirstlane(tid >> 6), lane = tid & 63, wr = wid >> 2, wc = wid & 3, fr = lane & 15, fq = lane >> 4;
    const int K = g.K, nt = K / BK;
    unsigned voffA[2], voffB[2];
#pragma unroll
    for (int i = 0; i < 2; ++i) { int R, C; stage_rc(tid * 16 + i * 8192, R, C); const int Rb = E.perm ? ((R & ~31) + perm32(R & 31)) : R;
        voffA[i] = (unsigned)(R * K + C) * 2u; voffB[i] = (unsigned)(Rb * K + C) * 2u; }
    const size_t kstep = (size_t)(BK * 2);
    const size_t hstep = (size_t)HALF * K * 2;
    const size_t tstep = 2 * hstep;
    const unsigned ldsw = (unsigned)wid * 1024u;
    const int aoff = lds_byte(wr * 64 + fr, fq * 8), boff = lds_byte(wc * 32 + fr, fq * 8);
#define PG8_SA(b, h) (((b) * 2 + (h)) * HTB)
#define PG8_SB(b, h) ((4 + (b) * 2 + (h)) * HTB)
#define PG8_STAGE(bufoff, gbase, voff) do { _Pragma("unroll") for (int _i = 0; _i < 2; ++_i) \
        __builtin_amdgcn_global_load_lds((const unsigned*)((const char*)(gbase) + (voff)[_i]), (PG8_LAS unsigned*)(lds + (bufoff) + ldsw + _i * 8192), 16, 0, 0); } while (0)
#define PG8_LDA(dst, b, h) do { _Pragma("unroll") for (int m = 0; m < 4; ++m) _Pragma("unroll") for (int k = 0; k < 2; ++k) dst[m][k] = *(const PG8_LAS bf16x8*)(lds + PG8_SA(b, h) + aoff + m * 2048 + k * 1024); } while (0)
#define PG8_LDB(dst, b, h) do { _Pragma("unroll") for (int n = 0; n < 2; ++n) _Pragma("unroll") for (int k = 0; k < 2; ++k) dst[n][k] = *(const PG8_LAS bf16x8*)(lds + PG8_SB(b, h) + boff + n * 2048 + k * 1024); } while (0)
#define PG8_MMA(ai, bj, At, Bt) do { __builtin_amdgcn_s_setprio(1); _Pragma("unroll") for (int m = 0; m < 4; ++m) _Pragma("unroll") for (int n = 0; n < 2; ++n) _Pragma("unroll") for (int k = 0; k < 2; ++k) \
        acc[ai][bj][m][n] = __builtin_amdgcn_mfma_f32_16x16x32_bf16(Bt[n][k], At[m][k], acc[ai][bj][m][n], 0, 0, 0); __builtin_amdgcn_s_setprio(0); } while (0)
#define PG8_WAIT_V(n) asm volatile("s_waitcnt vmcnt(" #n ")" ::: "memory")
#define PG8_WAIT_L(n) asm volatile("s_waitcnt lgkmcnt(" #n ")" ::: "memory")
#define PG8_BAR __builtin_amdgcn_s_barrier()
#define PG8_SCHED __builtin_amdgcn_sched_barrier(0)
    Unit cur, nxt; int ui = 0;
    if (!S.next(0, cur)) return;
    f32x4 acc[2][2][4][2];
#pragma unroll
    for (int a = 0; a < 2; ++a)
#pragma unroll
        for (int b = 0; b < 2; ++b)
#pragma unroll
            for (int m = 0; m < 4; ++m)
#pragma unroll
                for (int n = 0; n < 2; ++n) acc[a][b][m][n] = (f32x4){0.f, 0.f, 0.f, 0.f};
    bf16x8 At[4][2], B0[2][2], B1[2][2];
    const char* cA = (const char*)g.A + (size_t)cur.pm * tstep; const char* cB = (const char*)g.Bt + (size_t)cur.pn * tstep;
    S.a_ready(cur);
    if constexpr (SP2) {
        PG8_STAGE(PG8_SB(0, 0), cB, voffB); PG8_STAGE(PG8_SB(0, 1), cB + hstep, voffB); PG8_STAGE(PG8_SA(0, 0), cA, voffA); PG8_STAGE(PG8_SA(0, 1), cA + hstep, voffA);
        if (wr == 1) PG8_BAR;
        PG8_WAIT_V(2); PG8_BAR;
        PG8_STAGE(PG8_SB(1, 0), cB + kstep, voffB); PG8_STAGE(PG8_SA(1, 0), cA + kstep, voffA); PG8_STAGE(PG8_SB(1, 1), cB + hstep + kstep, voffB);
        PG8_WAIT_V(6); PG8_BAR;
    } else {
        PG8_STAGE(PG8_SB(0, 0), cB, voffB); PG8_STAGE(PG8_SA(0, 0), cA, voffA); PG8_STAGE(PG8_SB(0, 1), cB + hstep, voffB); PG8_STAGE(PG8_SA(0, 1), cA + hstep, voffA);
        if (wr == 1) PG8_BAR;
        PG8_WAIT_V(4); PG8_BAR;
        PG8_STAGE(PG8_SB(1, 0), cB + kstep, voffB); PG8_STAGE(PG8_SA(1, 0), cA + kstep, voffA); PG8_STAGE(PG8_SB(1, 1), cB + hstep + kstep, voffB);
        PG8_WAIT_V(6); PG8_BAR;
    }
    for (;;) {
        const bool has_next = S.next(ui + 1, nxt);
        const char* nA = has_next ? (const char*)g.A + (size_t)nxt.pm * tstep : cA; const char* nB = has_next ? (const char*)g.Bt + (size_t)nxt.pn * tstep : cB;
        for (int t = 0; t < nt; t += 2) {
            const bool last = (t == nt - 2);
            const char* a1 = cA + (size_t)(t + 1) * kstep;
            const char* a2 = last ? nA : cA + (size_t)(t + 2) * kstep; const char* b2 = last ? nB : cB + (size_t)(t + 2) * kstep;
            const char* a3 = a2 + kstep; const char* b3 = b2 + kstep;
            if (last && has_next) S.a_ready(nxt);
            if constexpr (SP2) {
            PG8_LDB(B0, 0, 0); PG8_LDB(B1, 0, 1); PG8_SCHED; PG8_LDA(At, 0, 0); PG8_STAGE(PG8_SA(1, 1), a1 + hstep, voffA);
            PG8_WAIT_V(8); PG8_WAIT_L(0); PG8_BAR; PG8_MMA(0, 0, At, B0); PG8_MMA(0, 1, At, B1); PG8_BAR; PG8_SCHED;
            PG8_LDA(At, 0, 1); PG8_STAGE(PG8_SB(0, 0), b2, voffB); PG8_STAGE(PG8_SB(0, 1), b2 + hstep, voffB); PG8_STAGE(PG8_SA(0, 0), a2, voffA);
            PG8_WAIT_V(8); PG8_WAIT_L(0); PG8_BAR; PG8_MMA(1, 0, At, B0); PG8_MMA(1, 1, At, B1); PG8_BAR; PG8_SCHED;
            PG8_LDB(B0, 1, 0); PG8_LDB(B1, 1, 1); PG8_SCHED; PG8_LDA(At, 1, 0); PG8_STAGE(PG8_SA(0, 1), a2 + hstep, voffA);
            PG8_WAIT_V(8); PG8_WAIT_L(0); PG8_BAR; PG8_MMA(0, 0, At, B0); PG8_MMA(0, 1, At, B1); PG8_BAR; PG8_SCHED;
            PG8_LDA(At, 1, 1); PG8_STAGE(PG8_SB(1, 0), b3, voffB); PG8_STAGE(PG8_SB(1, 1), b3 + hstep, voffB); PG8_STAGE(PG8_SA(1, 0), a3, voffA);
            PG8_WAIT_V(8); PG8_WAIT_L(0); PG8_BAR; PG8_MMA(1, 0, At, B0); PG8_MMA(1, 1, At, B1); PG8_BAR; PG8_SCHED;
            } else {
            PG8_LDB(B0, 0, 0); PG8_SCHED; PG8_LDA(At, 0, 0); PG8_STAGE(PG8_SA(1, 1), a1 + hstep, voffA);
            PG8_WAIT_L(8); PG8_BAR; PG8_WAIT_L(0); PG8_MMA(0, 0, At, B0); PG8_BAR; PG8_SCHED;
            PG8_LDB(B1, 0, 1); PG8_STAGE(PG8_SB(0, 0), b2, voffB);
            PG8_BAR; PG8_WAIT_L(0); PG8_MMA(0, 1, At, B1); PG8_BAR;
            PG8_LDA(At, 0, 1); PG8_STAGE(PG8_SA(0, 0), a2, voffA);
            PG8_BAR; PG8_WAIT_L(0); PG8_MMA(1, 0, At, B0); PG8_BAR; PG8_SCHED;
            PG8_STAGE(PG8_SB(0, 1), b2 + hstep, voffB);
            PG8_WAIT_V(6); PG8_BAR; PG8_MMA(1, 1, At, B1); PG8_BAR;
            PG8_LDB(B0, 1, 0); PG8_SCHED; PG8_LDA(At, 1, 0); PG8_STAGE(PG8_SA(0, 1), a2 + hstep, voffA);
            PG8_WAIT_L(8); PG8_BAR; PG8_WAIT_L(0); PG8_MMA(0, 0, At, B0); PG8_BAR; PG8_SCHED;
            PG8_LDB(B1, 1, 1); PG8_STAGE(PG8_SB(1, 0), b3, voffB);
            PG8_BAR; PG8_WAIT_L(0); PG8_MMA(0, 1, At, B1); PG8_BAR;
            PG8_LDA(At, 1, 1); PG8_STAGE(PG8_SA(1, 0), a3, voffA);
            PG8_BAR; PG8_WAIT_L(0); PG8_MMA(1, 0, At, B0); PG8_BAR; PG8_SCHED;
            PG8_STAGE(PG8_SB(1, 1), b3 + hstep, voffB);
            PG8_WAIT_V(6); PG8_BAR; PG8_MMA(1, 1, At, B1); PG8_BAR;
            }
        }
        if constexpr (ALIGN_EPI) { if (wr == 0) PG8_BAR; }
        if constexpr (!Epi::AFTER_DRAIN) { E(acc, cur, wr, wc, fr, fq); S.done(cur); }
        if (!has_next) break;
#pragma unroll
        for (int a = 0; a < 2; ++a)
#pragma unroll
            for (int b = 0; b < 2; ++b)
#pragma unroll
                for (int m = 0; m < 4; ++m)
#pragma unroll
                    for (int n = 0; n < 2; ++n) acc[a][b][m][n] = (f32x4){0.f, 0.f, 0.f, 0.f};
        cur = nxt; cA = nA; cB = nB; ++ui;
        if constexpr (ALIGN_EPI) { if (wr == 1) PG8_BAR; }
    }
    PG8_WAIT_V(0);
    if constexpr (!ALIGN_EPI) { if (wr == 0) PG8_BAR; }
    PG8_BAR;
    if constexpr (Epi::AFTER_DRAIN) { E.fused(acc, cur, wr, wc, fr, fq, lds, wid, lane); S.done(cur); }
#undef PG8_SA
#undef PG8_SB
#undef PG8_STAGE
#undef PG8_LDA
#undef PG8_LDB
#undef PG8_MMA
#undef PG8_WAIT_V
#undef PG8_WAIT_L
#undef PG8_BAR
#undef PG8_SCHED
}
}

#define LAS __attribute__((address_space(3)))
#define GAS __attribute__((address_space(1)))
typedef unsigned short bf16;
typedef float f32x4 __attribute__((ext_vector_type(4)));
typedef unsigned u32x4 __attribute__((ext_vector_type(4)));
typedef unsigned u32x2 __attribute__((ext_vector_type(2)));
typedef short bf16x8 __attribute__((ext_vector_type(8)));

constexpr int BATCH = 16, SEQ = 4096, NMETA = 16, L = SEQ + NMETA, M = BATCH * L, DM = 1024, DEPTH = 4, DFF = 2816, PC = 3072;
constexpr int PER_LAYER = 13, NPH = DEPTH * PER_LAYER + 1;
constexpr int LDS_BYTES = 147456;
static_assert(M % 256 == 0, "M tiles");

constexpr size_t WS_CTL = 0;
constexpr size_t WS_H = 1u << 20;
constexpr size_t WS_PROJ = WS_H + (size_t)M * DM * 4;
constexpr size_t WS_Y = WS_PROJ + (size_t)M * PC * 2;
constexpr size_t WS_W = WS_Y + (size_t)M * 1280 * 2;
constexpr size_t WS_VF = WS_W + (size_t)37748736;
constexpr size_t WS_SR = WS_VF + (size_t)M * 256 * 2;
constexpr size_t WS_SK = WS_SR + (size_t)M * 256 * 2;
constexpr size_t WS_SKK = WS_SK + (size_t)M * 256 * 2;
constexpr size_t W_IN = 0, W_G = W_IN + (size_t)3072 * 1024 * 2, W_BA = W_G + (size_t)4096 * 1024 * 2, W_BB = W_BA + 1024 * 256 * 2, W_BC = W_BB + 1024 * 256 * 2,
                 W_BD = W_BC + 1024 * 512 * 2, W_OUT = W_BD + 1024 * 256 * 2, W_UP = W_OUT + 1024 * 1024 * 2, W_DN = W_UP + (size_t)5632 * 1024 * 2, W_L = W_DN + (size_t)1024 * 2816 * 2,
                 W_END = W_L + 1024 * 512 * 2;
constexpr size_t WS_END = WS_SR + (size_t)M * 1024 * 2;
static_assert(W_END == 37748736 && WS_SKK + (size_t)M * 256 * 2 <= WS_END && WS_END <= (size_t)1073741824, "workspace map");
constexpr size_t OFF_T = 0, OFF_MRG = (size_t)M * 1024 * 2;

struct Params { const float* in[29]; float* out; unsigned char* ws; int ph_lo, ph_hi; };

__device__ __forceinline__ int opq(int i) { asm volatile("" : "+s"(i)); return i; }
#define INP(i) (p.in[opq(i)])
__device__ __forceinline__ float bflo(unsigned w) { return __uint_as_float(w << 16); }
__device__ __forceinline__ float bfhi(unsigned w) { return __uint_as_float(w & 0xffff0000u); }
__device__ __forceinline__ unsigned f2bf(float f) { unsigned u = __float_as_uint(f); return (u + 0x7fffu + ((u >> 16) & 1u)) >> 16; }
__device__ __forceinline__ unsigned pk2(float lo, float hi) { return f2bf(lo) | (f2bf(hi) << 16); }
__device__ __forceinline__ f32x4 up4bf(const u32x2 w) { return (f32x4){bflo(w.x), bfhi(w.x), bflo(w.y), bfhi(w.y)}; }
__device__ __forceinline__ f32x4 ld4bf(const bf16* p) { const u32x2 w = *(const u32x2*)p; return (f32x4){bflo(w.x), bfhi(w.x), bflo(w.y), bfhi(w.y)}; }
__device__ __forceinline__ void st4bf(bf16* p, f32x4 v) { u32x2 w; w.x = pk2(v.x, v.y); w.y = pk2(v.z, v.w); *(u32x2*)p = w; }
__device__ __forceinline__ float sigm(float x) { return __builtin_amdgcn_rcpf(1.0f + __expf(-x)); }
__device__ __forceinline__ float shx(float v, int o, int lane) { return __int_as_float(__builtin_amdgcn_ds_bpermute((lane ^ o) << 2, __float_as_int(v))); }
__device__ __forceinline__ float wave_sum(float v, int lane) {
#pragma unroll
    for (int o = 1; o < 64; o <<= 1) v += shx(v, o, lane);
    return v;
}
template <int CTRL> __device__ __forceinline__ float dppf(float x) { return __int_as_float(__builtin_amdgcn_mov_dpp(__float_as_int(x), CTRL, 0xF, 0xF, true)); }
__device__ __forceinline__ float row16_sum(float x) {
    x += dppf<0xB1>(x);
    x += dppf<0x4E>(x);
    x += dppf<0x141>(x);
    x += dppf<0x140>(x);
    return x;
}
#define OPQ_TID(tid) asm volatile("" : "+v"(tid))
#define WAVE_IDS(tid) const int lane = tid & 63, wave = __builtin_amdgcn_readfirstlane(tid >> 6), gw = blockIdx.x * 8 + wave, ngw = gridDim.x * 8; (void)lane; (void)wave; (void)gw; (void)ngw
#define LDS_WAIT() asm volatile("s_waitcnt lgkmcnt(0)" ::: "memory")

template <int MODE>
__device__ __forceinline__ void norm_phase(const Params& p, const float* gamma, int tid) {
    OPQ_TID(tid); WAVE_IDS(tid);
    bf16* H = (bf16*)(p.ws + WS_H);
    bf16* Z = (bf16*)p.out;
    f32x4 gv[4];
#pragma unroll
    for (int j = 0; j < 4; ++j) gv[j] = ((const f32x4*)gamma)[lane + 64 * j];
    for (int m0 = gw; m0 < M; m0 += 4 * ngw) {
        f32x4 vv[4][4];
#pragma unroll
        for (int q = 0; q < 4; ++q) { const int m = m0 + q * ngw;
            if (m < M) { const int b = m / L, t = m - b * L;
                if (MODE == 1) { const float* src = (t < NMETA) ? INP(1) + (size_t)t * DM : INP(0) + ((size_t)b * SEQ + (t - NMETA)) * DM;
#pragma unroll
                    for (int j = 0; j < 4; ++j) vv[q][j] = __builtin_nontemporal_load((const f32x4*)src + lane + 64 * j);
                } else {
#pragma unroll
                    for (int j = 0; j < 4; ++j) vv[q][j] = ld4bf(H + (size_t)m * DM + 4 * lane + 256 * j);
                } } }
#pragma unroll
        for (int q = 0; q < 4; ++q) { const int m = m0 + q * ngw;
            if (m < M) { const int b = m / L, t = m - b * L;
                f32x4 v[4]; float ss = 0.f;
#pragma unroll
                for (int j = 0; j < 4; ++j) { v[j] = vv[q][j]; ss += (v[j].x * v[j].x + v[j].y * v[j].y) + (v[j].z * v[j].z + v[j].w * v[j].w); }
                ss = wave_sum(ss, lane);
                const float rstd = rsqrtf(ss * (1.0f / DM) + 1e-6f);
                if (MODE == 1) {
#pragma unroll
                    for (int j = 0; j < 4; ++j) st4bf(H + (size_t)m * DM + 4 * lane + 256 * j, v[j]);
                }
                if (MODE == 2) {
                    if (t >= NMETA) { f32x4* o4 = (f32x4*)(p.out + ((size_t)b * SEQ + (t - NMETA)) * DM);
#pragma unroll
                        for (int j = 0; j < 4; ++j) o4[lane + 64 * j] = v[j] * rstd * gv[j]; }
                } else {
#pragma unroll
                    for (int j = 0; j < 4; ++j) st4bf(Z + (size_t)m * DM + 4 * lane + 256 * j, v[j] * rstd * gv[j]);
                }
            } }
    }
}

__device__ __forceinline__ void tr_item(const float* W, int N, int k0, int n0, bf16* D, int ld, int kd0, int nsub, int upmode, LAS float* scr, int lane) {
    float wv[32];
#pragma unroll
    for (int i = 0; i < 32; ++i) wv[i] = __builtin_nontemporal_load(W + (size_t)(k0 + 2 * i + (lane >> 5)) * N + n0 + (lane & 31));
#pragma unroll
    for (int i = 0; i < 32; ++i) scr[(2 * i + (lane >> 5)) * 33 + (lane & 31)] = wv[i];
    LDS_WAIT();
    const int c = lane & 7;
#pragma unroll
    for (int j = 0; j < 4; ++j) { const int n = (lane >> 3) + 8 * j; const LAS float* s = scr + (8 * c) * 33 + n;
        u32x4 o; o.x = pk2(s[0 * 33], s[1 * 33]); o.y = pk2(s[2 * 33], s[3 * 33]); o.z = pk2(s[4 * 33], s[5 * 33]); o.w = pk2(s[6 * 33], s[7 * 33]);
        const int ng = n0 + n; int dr;
        if (upmode == 1) { const int up = ng >= DFF ? 1 : 0, jj = ng - up * DFF; dr = (jj >> 4) * 32 + up * 16 + (jj & 15); }
        else if (upmode == 2) { const int bi = ng >> 10, jj = ng & 1023; dr = 256 * (jj >> 6) + 128 * (bi >> 1) + 32 * ((jj >> 4) & 3) + 16 * (bi & 1) + (jj & 15); }
        else dr = ng - nsub;
        *(u32x4*)(D + (size_t)dr * ld + kd0 + 8 * c) = o; }
    LDS_WAIT();
}
__device__ __forceinline__ void convert_phase(const Params& p, int layer, LAS unsigned char* lds, int tid) {
    OPQ_TID(tid); WAVE_IDS(tid);
    LAS float* scr = (LAS float*)(lds + wave * 16384);
    unsigned char* wb = p.ws + WS_W;
    constexpr int I_IN = 16 * 224, I_BR = 20 * 32, I_OUT = 16 * 32, I_UP = 16 * 176, I_DN = 44 * 32, NIT = I_IN + I_BR + I_OUT + I_UP + I_DN;
    const float* w_in = INP(5) + (size_t)layer * 1024 * 7168;
    const float* w_br = INP(6) + (size_t)layer * 1280 * 1024;
    const float* w_out = INP(7) + (size_t)layer * 1024 * 1024;
    const float* w_up = INP(27) + (size_t)layer * 1024 * 5632;
    const float* w_dn = INP(28) + (size_t)layer * 2816 * 1024;
    for (int it = gw; it < NIT; it += ngw) {
        int r = it;
        if (r < I_IN) { const int kb = r / 224, nb = r % 224, n0 = 32 * nb;
            if (n0 < 4096) tr_item(w_in, 7168, 64 * kb, n0, (bf16*)(wb + W_G), 1024, 64 * kb, 0, 2, scr, lane);
            else tr_item(w_in, 7168, 64 * kb, n0, (bf16*)(wb + W_IN), 1024, 64 * kb, 4096, 0, scr, lane);
            continue; }
        r -= I_IN;
        if (r < I_BR) { const int kb = r / 32, nb = r % 32, k0 = 64 * kb;
            if (kb < 4) tr_item(w_br, 1024, k0, 32 * nb, (bf16*)(wb + W_BA), 256, k0, 0, 0, scr, lane);
            else if (kb < 8) tr_item(w_br, 1024, k0, 32 * nb, (bf16*)(wb + W_BB), 256, k0 - 256, 0, 0, scr, lane);
            else if (kb < 16) tr_item(w_br, 1024, k0, 32 * nb, (bf16*)(wb + W_BC), 512, k0 - 512, 0, 0, scr, lane);
            else tr_item(w_br, 1024, k0, 32 * nb, (bf16*)(wb + W_BD), 256, k0 - 1024, 0, 0, scr, lane);
            continue; }
        r -= I_BR;
        if (r < I_OUT) { const int kb = r / 32, nb = r % 32; tr_item(w_out, 1024, 64 * kb, 32 * nb, (bf16*)(wb + W_OUT), 1024, 64 * kb, 0, 0, scr, lane); continue; }
        r -= I_OUT;
        if (r < I_UP) { const int kb = r / 176, nb = r % 176; tr_item(w_up, 5632, 64 * kb, 32 * nb, (bf16*)(wb + W_UP), 1024, 64 * kb, 0, 1, scr, lane); continue; }
        r -= I_UP;
        { const int kb = r / 32, nb = r % 32; tr_item(w_dn, 1024, 64 * kb, 32 * nb, (bf16*)(wb + W_DN), 2816, 64 * kb, 0, 0, scr, lane); }
    }
    {
        bf16* WL = (bf16*)(wb + W_L);
        const float* wup = INP(9) + (size_t)layer * 64 * 256;
        const float* aup = INP(11) + (size_t)layer * 64 * 256;
        const float* gup = INP(13) + (size_t)layer * 128 * 256;
        const float* vdn = INP(19) + (size_t)(layer > 0 ? layer - 1 : 0) * 256 * 32;
        const float* vup = INP(20) + (size_t)(layer > 0 ? layer - 1 : 0) * 32 * 256;
        const int nthr = gridDim.x * 512;
        for (int idx = blockIdx.x * 512 + tid; idx < 1024 * 512; idx += nthr) {
            const int n = idx >> 9, kx = idx & 511; float v = 0.f;
            if (n < 256) { if (kx < 64) v = wup[kx * 256 + n]; }
            else if (n < 512) { if (kx >= 64 && kx < 128) v = aup[(kx - 64) * 256 + (n - 256)]; }
            else if (n < 768) { if (kx >= 128 && kx < 256) v = gup[(kx - 128) * 256 + (n - 512)]; }
            else { if (kx >= 256 && layer > 0) { float s = 0.f;
#pragma unroll 8
                    for (int j = 0; j < 32; ++j) s += vdn[(kx - 256) * 32 + j] * vup[j * 256 + (n - 768)];
                    v = s; } }
            WL[idx] = (bf16)f2bf(v);
        }
    }
    if (layer == 0 && blockIdx.x == 0 && tid < 256) {
        const float* d = INP(25); float* LBT = (float*)(p.ws + WS_CTL + 4096);
        const float d0 = d[tid], d1 = d[256 + tid], d2 = d[512 + tid], d3 = d[768 + tid];
        const float mx = fmaxf(fmaxf(d0, d1), fmaxf(d2, d3));
        const float e0 = expf(d0 - mx), e1 = expf(d1 - mx), e2 = expf(d2 - mx), e3 = expf(d3 - mx);
        const float inv = 1.0f / (e0 + e1 + e2 + e3);
        LBT[tid] = 0.f; LBT[256 + tid] = e1 * inv; LBT[512 + tid] = (e1 + e2) * inv; LBT[768 + tid] = (e1 + e2 + e3) * inv;
    }
}

__device__ __forceinline__ void prep1_phase(const Params& p, int layer, int tid) {
    OPQ_TID(tid); WAVE_IDS(tid);
    const bf16* PROJ = (const bf16*)(p.ws + WS_PROJ);
    bf16* XV = (bf16*)(p.ws + WS_Y); bf16* SR = (bf16*)(p.ws + WS_SR); bf16* SK = (bf16*)(p.ws + WS_SK);
    const float* mu = INP(8) + (size_t)layer * 1024;
    f32x4 mu4[4];
#pragma unroll
    for (int s = 0; s < 4; ++s) mu4[s] = *(const f32x4*)(mu + s * 256 + 4 * lane);
    const int c4 = 4 * lane;
    for (int m0 = gw; m0 < M; m0 += 4 * ngw) {
        u32x2 ra[4][4], rb[4][4];
#pragma unroll
        for (int q = 0; q < 4; ++q) { const int m = m0 + q * ngw;
            if (m < M) { const int t = m % L; const bf16* cur = PROJ + (size_t)m * PC;
#pragma unroll
                for (int s = 0; s < 4; ++s) { ra[q][s] = *(const u32x2*)(cur + s * 256 + c4); rb[q][s] = (u32x2){0u, 0u}; if (t > 0) rb[q][s] = *(const u32x2*)(cur - PC + s * 256 + c4); } } }
#pragma unroll
        for (int q = 0; q < 4; ++q) { const int m = m0 + q * ngw;
            if (m < M) {
                f32x4 u[4];
#pragma unroll
                for (int s = 0; s < 4; ++s) { const f32x4 a = up4bf(ra[q][s]), b = up4bf(rb[q][s]); u[s] = a + (b - a) * mu4[s]; }
                st4bf(SR + (size_t)m * 256 + c4, u[0]);
                st4bf(SK + (size_t)m * 256 + c4, u[1]);
                st4bf(XV + (size_t)m * 512 + 256 + c4, u[2]);
                f32x4 x = u[3];
                if (c4 < 64) {
#pragma unroll
                    for (int e = 0; e < 4; ++e) { const float tt = __expf(2.0f * x[e]); x[e] = 1.0f - 2.0f * __builtin_amdgcn_rcpf(tt + 1.0f); }
                } else if (c4 >= 128) {
#pragma unroll
                    for (int e = 0; e < 4; ++e) x[e] = sigm(x[e]);
                }
                st4bf(XV + (size_t)m * 512 + c4, x);
            } }
    }
}

__device__ __forceinline__ void prep2_phase(const Params& p, int layer, int tid) {
    OPQ_TID(tid); WAVE_IDS(tid);
    bf16* PROJ = (bf16*)(p.ws + WS_PROJ);
    const bf16* XV = (const bf16*)(p.ws + WS_Y); bf16* SK = (bf16*)(p.ws + WS_SK); bf16* SKK = (bf16*)(p.ws + WS_SKK); bf16* VF = (bf16*)(p.ws + WS_VF);
    const int c4 = 4 * lane;
    const f32x4 w0 = *(const f32x4*)(INP(10) + layer * 256 + c4), a0 = *(const f32x4*)(INP(12) + layer * 256 + c4);
    const f32x4 kkw = *(const f32x4*)(INP(14) + layer * 256 + c4), kaw = *(const f32x4*)(INP(15) + layer * 256 + c4);
    f32x4 vr0 = (f32x4){0.f, 0.f, 0.f, 0.f};
    if (layer > 0) vr0 = *(const f32x4*)(INP(21) + (layer - 1) * 256 + c4);
    for (int m0 = gw; m0 < M; m0 += 4 * ngw) {
        u32x2 rw[4][6];
#pragma unroll
        for (int q = 0; q < 4; ++q) { const int m = m0 + q * ngw;
            if (m < M) { const bf16* pr = PROJ + (size_t)m * PC;
                rw[q][0] = *(const u32x2*)(pr + c4); rw[q][1] = *(const u32x2*)(pr + 256 + c4); rw[q][2] = *(const u32x2*)(pr + 768 + c4);
                rw[q][3] = *(const u32x2*)(XV + (size_t)m * 512 + 256 + c4); rw[q][4] = *(const u32x2*)(SK + (size_t)m * 256 + c4);
                rw[q][5] = (u32x2){0u, 0u}; if (layer > 0) rw[q][5] = *(const u32x2*)(VF + (size_t)m * 256 + c4); } }
#pragma unroll
        for (int q = 0; q < 4; ++q) { const int m = m0 + q * ngw;
            if (m < M) {
                bf16* pr = PROJ + (size_t)m * PC;
                const f32x4 wl = up4bf(rw[q][0]), al = up4bf(rw[q][1]), vr = up4bf(rw[q][2]), v = up4bf(rw[q][3]), k = up4bf(rw[q][4]);
                f32x4 lw, a, kkv, kn, vn;
                float ss = 0.f;
#pragma unroll
                for (int e = 0; e < 4; ++e) {
                    const float x = w0[e] + wl[e];
                    const float sp = fmaxf(-x, 0.f) + __logf(1.0f + __expf(-fabsf(x)));
                    lw[e] = -__expf(-sp - 0.5f);
                    a[e] = sigm(a0[e] + al[e]);
                    kkv[e] = k[e] * kkw[e]; ss += kkv[e] * kkv[e];
                    kn[e] = k[e] * (1.0f + (a[e] - 1.0f) * kaw[e]);
                }
                ss = row16_sum(ss);
                const float inv = 1.0f / fmaxf(sqrtf(ss), 1e-12f);
                if (layer > 0) { const f32x4 vf = up4bf(rw[q][5]);
#pragma unroll
                    for (int e = 0; e < 4; ++e) vn[e] = v[e] + (vf[e] - v[e]) * sigm(vr0[e] + vr[e]);
                } else { vn = v; st4bf(VF + (size_t)m * 256 + c4, v); }
                f32x4 kkn = kkv * inv;
                st4bf(pr + c4, lw);
                st4bf(pr + 256 + c4, kkn * a);
                st4bf(pr + 768 + c4, vn);
                st4bf(SK + (size_t)m * 256 + c4, kn);
                st4bf(SKK + (size_t)m * 256 + c4, kkn);
            } }
    }
}

__device__ __forceinline__ void scan_phase(const Params& p, int layer, LAS unsigned char* lds, int tid) {
    OPQ_TID(tid);
    typedef float f32x2 __attribute__((ext_vector_type(2)));
    const bf16* PROJ = (const bf16*)(p.ws + WS_PROJ);
    const bf16* SR = (const bf16*)(p.ws + WS_SR); const bf16* SK = (const bf16*)(p.ws + WS_SK); const bf16* SKK = (const bf16*)(p.ws + WS_SKK);
    bf16* YA = (bf16*)(p.ws + WS_Y); bf16* YD = (bf16*)(p.ws + WS_Y + (size_t)M * 2048);
    const float* LBT = (const float*)(p.ws + WS_CTL + 4096) + layer * 256;
    constexpr int O_RV = 5120, O_HW = 5376, O_HV = 7424, IN_F = 7680, OUT_F = 2048, O_HO = 1024;
    LAS float* INB = (LAS float*)lds;
    LAS float* OUTB = INB + 2 * IN_F;
    const int cw = tid >> 6, lane = tid & 63, kq = lane & 15, lt = tid & 127;
    const bool cR = cw < 4, cH = (cw == 4) || (cw == 5);
    const int rrow = cw * 4 + (lane >> 4);
    const int r0 = (cw & 1) * 8 + (lane >> 4) * 2;
    constexpr int NCH = L / 16;
    for (int item = blockIdx.x; item < 256; item += gridDim.x) {
        const int b = item >> 4, h = (item >> 2) & 3, rq = item & 3;
        const size_t mb = (size_t)b * L;
        const bf16* sp[8]; int sld[8], sk[8], sd[8];
        float lbv[8];
#pragma unroll
        for (int e = 0; e < 8; ++e) lbv[e] = 0.f;
#pragma unroll
        for (int i = 0; i < 8; ++i) {
            const int idx = lt + 128 * i; sp[i] = PROJ; sld[i] = 0; sk[i] = -1; sd[i] = 0;
            if (idx < 640) { const int vec = idx >> 7, rem = idx & 127, st = rem >> 3, ch = rem & 7; const int co = h * 64 + ch * 8;
                if (vec == 0) { sp[i] = SKK + (mb + st) * 256 + co; sld[i] = 256; } else if (vec == 1) { sp[i] = PROJ + (mb + st) * PC + co; sld[i] = PC; }
                else if (vec == 2) { sp[i] = PROJ + (mb + st) * PC + 256 + co; sld[i] = PC; } else if (vec == 3) { sp[i] = SK + (mb + st) * 256 + co; sld[i] = 256; }
                else { sp[i] = SR + (mb + st) * 256 + co; sld[i] = 256; }
                sk[i] = (vec == 1) ? 1 : 0; sd[i] = ((st * 16 + 2 * ch) * 5 + vec) * 4; }
            else if (idx < 672) { const int vi = idx - 640, st = vi >> 1, hf = vi & 1; sp[i] = PROJ + (mb + st) * PC + 768 + h * 64 + rq * 16 + hf * 8; sld[i] = PC; sk[i] = 2; sd[i] = O_RV + st * 16 + hf * 8; }
            else if (idx < 928) { const int j = idx - 672, st = (j & 127) >> 3, ch = j & 7;
                if (j < 128) { sp[i] = PROJ + (mb + st) * PC + 2048 + h * 64 + ch * 8; sk[i] = 3; sd[i] = O_HW + ((st * 16 + 2 * ch) * 2 + 1) * 4; }
                else { sp[i] = PROJ + (mb + st) * PC + 2304 + h * 64 + ch * 8; sk[i] = 4; sd[i] = O_HW + ((st * 16 + 2 * ch) * 2) * 4;
#pragma unroll
                    for (int e = 0; e < 8; ++e) lbv[e] = LBT[h * 64 + ch * 8 + e]; }
                sld[i] = PC; }
            else if (idx < 960) { const int vi = idx - 928, st = vi >> 1, hf = vi & 1; sp[i] = PROJ + (mb + st) * PC + 2560 + h * 64 + rq * 16 + hf * 8; sld[i] = PC; sk[i] = 2; sd[i] = O_HV + st * 16 + hf * 8; }
        }
        u32x4 preA[8], preB[8];
#pragma unroll
        for (int i = 0; i < 8; ++i) { preA[i] = (u32x4){0, 0, 0, 0}; preB[i] = (u32x4){0, 0, 0, 0}; }
#define SC_LOAD(P, chunk) do { _Pragma("unroll") for (int i = 0; i < 8; ++i) if (sk[i] >= 0) P[i] = *(const u32x4*)(sp[i] + (size_t)(chunk) * 16 * sld[i]); } while (0)
#define SC_ST4(off, a, b, c, d) *(LAS f32x4*)(dstb + (off)) = (f32x4){a, b, c, d}
#define SC_STAGE(P, dstb) do { _Pragma("unroll") for (int i = 0; i < 8; ++i) if (sk[i] >= 0) { \
            float f[8]; f[0] = bflo(P[i].x); f[1] = bfhi(P[i].x); f[2] = bflo(P[i].y); f[3] = bfhi(P[i].y); f[4] = bflo(P[i].z); f[5] = bfhi(P[i].z); f[6] = bflo(P[i].w); f[7] = bfhi(P[i].w); \
            const int o_ = sd[i]; \
            if (sk[i] == 0) { SC_ST4(o_, f[0], f[1], f[2], f[3]); SC_ST4(o_ + 20, f[4], f[5], f[6], f[7]); } \
            else if (sk[i] == 1) { _Pragma("unroll") for (int e = 0; e < 8; ++e) f[e] = __expf(f[e]); SC_ST4(o_, f[0], f[1], f[2], f[3]); SC_ST4(o_ + 20, f[4], f[5], f[6], f[7]); } \
            else if (sk[i] == 2) { SC_ST4(o_, f[0], f[1], f[2], f[3]); SC_ST4(o_ + 4, f[4], f[5], f[6], f[7]); } \
            else if (sk[i] == 3) { _Pragma("unroll") for (int e = 0; e < 8; ++e) f[e] = f[e] * sigm(f[e]); SC_ST4(o_, f[0], f[1], f[2], f[3]); SC_ST4(o_ + 8, f[4], f[5], f[6], f[7]); } \
            else { _Pragma("unroll") for (int e = 0; e < 8; ++e) f[e] = lbv[e] + (1.0f - lbv[e]) * sigm(f[e]); SC_ST4(o_, f[0], f[1], f[2], f[3]); SC_ST4(o_ + 8, f[4], f[5], f[6], f[7]); } } } while (0)
        if (!cR && !cH) { SC_LOAD(preA, 0); SC_LOAD(preB, 1); { LAS float* dstb = INB; SC_STAGE(preA, dstb); } SC_LOAD(preA, 2); }
        f32x2 S01 = (f32x2){0.f, 0.f}, S23 = S01;
        f32x2 H0 = (f32x2){0.f, 0.f}, H1 = H0, H2 = H0, H3 = H0;
        __syncthreads();
        for (int c = 0; c < NCH; ++c) {
            const int bi = c & 1;
            LAS float* inb = INB + bi * IN_F; LAS float* outb = OUTB + bi * OUT_F;
            if (cR) {
                const LAS float* RW = inb; const LAS float* RV = inb + O_RV; LAS float* RO = outb;
                const LAS f32x4* q = (const LAS f32x4*)(RW + kq * 20);
                f32x4 kk = q[0], w = q[1], bb = q[2], k = q[3], r = q[4]; float v = RV[rrow];
#pragma unroll
                for (int s = 0; s < 16; ++s) {
                    f32x4 nkk = kk, nw = w, nbb = bb, nk = k, nr = r; float nv = v;
                    if (s < 15) { const LAS f32x4* qn = (const LAS f32x4*)(RW + ((s + 1) * 16 + kq) * 20);
                        nkk = qn[0]; nw = qn[1]; nbb = qn[2]; nk = qn[3]; nr = qn[4]; nv = RV[(s + 1) * 16 + rrow]; }
                    const f32x2 p2 = S01 * kk.xy + S23 * kk.zw;
                    float pd = p2.x + p2.y;
                    const f32x2 a01 = S01 * w.xy + k.xy * v, a23 = S23 * w.zw + k.zw * v;
                    pd = row16_sum(pd);
                    S01 = a01 - bb.xy * pd; S23 = a23 - bb.zw * pd;
                    const f32x2 o2 = S01 * r.xy + S23 * r.zw;
                    float o = o2.x + o2.y;
                    o += dppf<0xB1>(o); o += dppf<0x4E>(o);
                    if ((kq & 3) == 0) RO[(s * 4 + (kq >> 2)) * 16 + rrow] = o;
                    kk = nkk; w = nw; bb = nbb; k = nk; r = nr; v = nv;
                }
            } else if (cH) {
                const LAS float* HW = inb + O_HW; const LAS float* HV = inb + O_HV; LAS float* HO = outb + O_HO;
                const LAS f32x4* q = (const LAS f32x4*)(HW + kq * 8);
                f32x4 f = q[0], qq = q[1]; f32x2 v2 = *(const LAS f32x2*)(HV + r0);
#pragma unroll
                for (int s = 0; s < 16; ++s) {
                    f32x4 nf = f, nqq = qq; f32x2 nv = v2;
                    if (s < 15) { const LAS f32x4* qn = (const LAS f32x4*)(HW + ((s + 1) * 16 + kq) * 8); nf = qn[0]; nqq = qn[1]; nv = *(const LAS f32x2*)(HV + (s + 1) * 16 + r0); }
                    H0 = v2 + (H0 - v2) * f.x; H1 = v2 + (H1 - v2) * f.y; H2 = v2 + (H2 - v2) * f.z; H3 = v2 + (H3 - v2) * f.w;
                    f32x2 o = (H0 * qq.x + H1 * qq.y) + (H2 * qq.z + H3 * qq.w);
                    o.x += dppf<0xB1>(o.x); o.y += dppf<0xB1>(o.y); o.x += dppf<0x4E>(o.x); o.y += dppf<0x4E>(o.y);
                    if ((kq & 3) == 0) *(LAS f32x2*)(HO + (s * 4 + (kq >> 2)) * 16 + r0) = o;
                    f = nf; qq = nqq; v2 = nv;
                }
            } else {
                if (c > 0) {
#pragma unroll
                    for (int i = 0; i < 2; ++i) { const int oi = lt + 128 * i;
                        const LAS float* po = OUTB + (bi ^ 1) * OUT_F + (oi >> 4) * 64 + (oi & 15);
                        const size_t mo = (mb + (size_t)(c - 1) * 16 + (oi >> 4)) * 256 + h * 64 + rq * 16 + (oi & 15);
                        YA[mo] = (bf16)f2bf((po[0] + po[16]) + (po[32] + po[48]));
                        YD[mo] = (bf16)f2bf((po[O_HO] + po[O_HO + 16]) + (po[O_HO + 32] + po[O_HO + 48])); }
                }
                if (c + 1 < NCH) {
                    if (bi == 0) { LAS float* dstb = INB + IN_F; SC_STAGE(preB, dstb); if (c + 3 < NCH) SC_LOAD(preB, c + 3); }
                    else { LAS float* dstb = INB; SC_STAGE(preA, dstb); if (c + 3 < NCH) SC_LOAD(preA, c + 3); }
                }
            }
            __syncthreads();
        }
        if (!cR && !cH) {
#pragma unroll
            for (int i = 0; i < 2; ++i) { const int oi = lt + 128 * i;
                const LAS float* po = OUTB + ((NCH - 1) & 1) * OUT_F + (oi >> 4) * 64 + (oi & 15);
                const size_t mo = (mb + (size_t)(NCH - 1) * 16 + (oi >> 4)) * 256 + h * 64 + rq * 16 + (oi & 15);
                YA[mo] = (bf16)f2bf((po[0] + po[16]) + (po[32] + po[48]));
                YD[mo] = (bf16)f2bf((po[O_HO] + po[O_HO + 16]) + (po[O_HO + 32] + po[O_HO + 48])); }
        }
        __syncthreads();
#undef SC_LOAD
#undef SC_ST4
#undef SC_STAGE
    }
}

__device__ __forceinline__ void post_phase(const Params& p, int layer, int tid) {
    OPQ_TID(tid); WAVE_IDS(tid);
    const bf16* PROJ = (const bf16*)(p.ws + WS_PROJ);
    const bf16* SR = (const bf16*)(p.ws + WS_SR); const bf16* SK = (const bf16*)(p.ws + WS_SK);
    bf16* YA = (bf16*)(p.ws + WS_Y); bf16* YD = (bf16*)(p.ws + WS_Y + (size_t)M * 2048);
    const int c4 = 4 * lane;
    const f32x4 lnw = *(const f32x4*)(INP(17) + layer * 256 + c4), lnb = *(const f32x4*)(INP(18) + layer * 256 + c4), rk = *(const f32x4*)(INP(16) + layer * 256 + c4);
    const f32x4 dn = *(const f32x4*)(INP(26) + layer * 256 + c4);
    for (int m0 = gw; m0 < M; m0 += 4 * ngw) {
        u32x2 rw[4][7];
#pragma unroll
        for (int q = 0; q < 4; ++q) { const int m = m0 + q * ngw;
            if (m < M) { const bf16* pr = PROJ + (size_t)m * PC;
                rw[q][0] = *(const u32x2*)(YA + (size_t)m * 256 + c4); rw[q][1] = *(const u32x2*)(SR + (size_t)m * 256 + c4); rw[q][2] = *(const u32x2*)(SK + (size_t)m * 256 + c4);
                rw[q][3] = *(const u32x2*)(pr + 768 + c4); rw[q][4] = *(const u32x2*)(pr + 512 + c4);
                rw[q][5] = *(const u32x2*)(YD + (size_t)m * 256 + c4); rw[q][6] = *(const u32x2*)(pr + 2816 + c4); } }
#pragma unroll
        for (int q = 0; q < 4; ++q) { const int m = m0 + q * ngw;
            if (m < M) {
                {
                    const f32x4 o = up4bf(rw[q][0]);
                    const float mean = row16_sum((o.x + o.y) + (o.z + o.w)) * (1.0f / 64.0f);
                    const f32x4 d = o - mean;
                    const float var = row16_sum((d.x * d.x + d.y * d.y) + (d.z * d.z + d.w * d.w)) * (1.0f / 64.0f);
                    const float rs = rsqrtf(var + 64e-5f);
                    const f32x4 r = up4bf(rw[q][1]), k = up4bf(rw[q][2]), v = up4bf(rw[q][3]), g = up4bf(rw[q][4]);
                    const f32x4 rkk = r * k * rk;
                    const float dot = row16_sum((rkk.x + rkk.y) + (rkk.z + rkk.w));
                    const f32x4 y = (d * rs * lnw + lnb + v * dot) * g;
                    st4bf(YA + (size_t)m * 256 + c4, y);
                }
                {
                    const f32x4 o = up4bf(rw[q][5]);
                    const float ms = row16_sum((o.x * o.x + o.y * o.y) + (o.z * o.z + o.w * o.w)) * (1.0f / 64.0f);
                    const float rs = rsqrtf(ms + 1e-6f);
                    const f32x4 g = up4bf(rw[q][6]);
                    f32x4 y;
#pragma unroll
                    for (int e = 0; e < 4; ++e) y[e] = o[e] * rs * dn[e] * (g[e] * sigm(g[e]));
                    st4bf(YD + (size_t)m * 256 + c4, y);
                }
            } }
    }
}

__device__ __forceinline__ void pool_phase(const Params& p, int layer, LAS unsigned char* lds, int tid) {
    OPQ_TID(tid);
    const bf16* PROJ = (const bf16*)(p.ws + WS_PROJ);
    bf16* YB = (bf16*)(p.ws + WS_Y + (size_t)M * 512);
    LAS float* U = (LAS float*)lds;
    LAS bf16* PB = (LAS bf16*)(lds + 48128);
    LAS bf16* MT = (LAS bf16*)(lds + 48128 + 16896);
    const float* mix = INP(22) + (size_t)layer * 4 * 64 * 64;
    const float* scale = INP(23) + layer * 256;
    const int wave = tid >> 6, lane = tid & 63, l15 = lane & 15, quad = lane >> 4;
    __syncthreads();
    for (int i = 0; i < 32; ++i) { const int idx = tid + 512 * i, g = idx >> 12, c = (idx >> 6) & 63, d = idx & 63; MT[(g * 64 + d) * 72 + c] = (bf16)f2bf(mix[idx] * scale[g * 64 + d]); }
    for (int tile = blockIdx.x; tile < M / 32; tile += gridDim.x) {
        const int m0 = tile * 32;
        __syncthreads();
#pragma unroll
        for (int i = 0; i < 3; ++i) { const int idx = tid + i * 512;
            if (idx < 47 * 32) { const int r = idx >> 5, ch = idx & 31, mm = m0 - 15 + r;
                u32x4 w = (u32x4){0, 0, 0, 0};
                if (mm >= 0) w = *(const u32x4*)(PROJ + (size_t)mm * PC + 1024 + ch * 8);
                LAS float* d = U + r * 256 + ch * 8;
                *(LAS f32x4*)d = (f32x4){bflo(w.x), bfhi(w.x), bflo(w.y), bfhi(w.y)}; *(LAS f32x4*)(d + 4) = (f32x4){bflo(w.z), bfhi(w.z), bflo(w.w), bfhi(w.w)}; } }
        __syncthreads();
        {
            const int c = tid & 255, rb = (tid >> 8) * 16, g = c >> 6, w = 2 << g; const float invw = 1.0f / (float)w;
            float sum = 0.f;
            for (int j = 0; j < w; ++j) sum += U[(15 + rb - j) * 256 + c];
            int t = (m0 + rb) % L;
            for (int i = 0; i < 16; ++i) {
                const int r = rb + i; const float cur = U[(15 + r) * 256 + c];
                if (i > 0) sum += cur - U[(15 + r - w) * 256 + c];
                float pv;
                if (t + 1 >= w) pv = sum * invw - cur;
                else { float s2 = 0.f; for (int j = 0; j <= t; ++j) s2 += U[(15 + r - j) * 256 + c]; pv = s2 / (float)(t + 1) - cur; }
                PB[r * 264 + c] = (bf16)f2bf(pv);
                t = (t + 1 == L) ? 0 : t + 1;
            }
        }
        __syncthreads();
        {
            const int g = wave >> 1, mt = wave & 1;
            bf16x8 a[2];
#pragma unroll
            for (int ks = 0; ks < 2; ++ks) a[ks] = *(const LAS bf16x8*)(PB + (mt * 16 + l15) * 264 + g * 64 + ks * 32 + quad * 8);
#pragma unroll
            for (int nt = 0; nt < 4; ++nt) {
                f32x4 acc = (f32x4){0.f, 0.f, 0.f, 0.f};
#pragma unroll
                for (int ks = 0; ks < 2; ++ks) { const bf16x8 bfr = *(const LAS bf16x8*)(MT + (g * 64 + nt * 16 + l15) * 72 + ks * 32 + quad * 8);
                    acc = __builtin_amdgcn_mfma_f32_16x16x32_bf16(a[ks], bfr, acc, 0, 0, 0); }
#pragma unroll
                for (int j = 0; j < 4; ++j) YB[(size_t)(m0 + mt * 16 + quad * 4 + j) * 256 + g * 64 + nt * 16 + l15] = (bf16)f2bf(acc[j]);
            }
        }
    }
}

template <bool EARLY>
__device__ __forceinline__ void attn_ct(const LAS bf16* Kb, const LAS bf16* Vb, const bf16x8 (&qf)[2], float fd, int rl, int l15, int smin, float slope2, float sink2, int lane, f32x4 (&oacc)[4], float& inv) {
    constexpr float LOG2E = 1.4426950408889634f;
    f32x4 sacc[9];
#pragma unroll
    for (int kk = 0; kk < 9; ++kk) sacc[kk] = (f32x4){0.f, 0.f, 0.f, 0.f};
#pragma unroll
    for (int kk = 0; kk < 9; ++kk)
#pragma unroll
        for (int ks = 0; ks < 2; ++ks) { const bf16x8 kf = *(const LAS bf16x8*)(Kb + kk * 16 * 72 + ks * 32);
            sacc[kk] = __builtin_amdgcn_mfma_f32_16x16x32_bf16(kf, qf[ks], sacc[kk], 0, 0, 0); if (ks == 1 && (kk & 1)) __builtin_amdgcn_sched_barrier(0); }
    float mx = -1e30f;
#pragma unroll
    for (int kk = 0; kk < 9; ++kk)
#pragma unroll
        for (int j = 0; j < 4; ++j) { const int rc = kk * 16 + j;
            float lg = sacc[kk][j] * (0.125f * LOG2E) - slope2 * (fd - (float)rc);
            if (kk == 0 || kk == 8 || EARLY) { bool ok = true;
                if (kk == 0) ok = (rc + rl) > l15;
                if (kk == 8) ok = (rc + rl) <= 128 + l15;
                if (EARLY) ok = ok && ((rc + rl) >= smin);
                lg = ok ? lg : -1e30f; }
            sacc[kk][j] = lg; mx = fmaxf(mx, lg); }
    mx = fmaxf(mx, shx(mx, 16, lane)); mx = fmaxf(mx, shx(mx, 32, lane)); mx = fmaxf(mx, sink2);
    float sum = 0.f;
#pragma unroll
    for (int kk = 0; kk < 9; ++kk)
#pragma unroll
        for (int j = 0; j < 4; ++j) { const float pe = __builtin_amdgcn_exp2f(sacc[kk][j] - mx); sacc[kk][j] = pe; sum += pe; }
    sum += shx(sum, 16, lane); sum += shx(sum, 32, lane); sum += __builtin_amdgcn_exp2f(sink2 - mx);
    inv = 1.0f / sum;
#pragma unroll
    for (int dt = 0; dt < 4; ++dt) oacc[dt] = (f32x4){0.f, 0.f, 0.f, 0.f};
#pragma unroll
    for (int kb = 0; kb < 5; ++kb) {
        u32x4 pw; pw.x = pk2(sacc[2 * kb][0], sacc[2 * kb][1]); pw.y = pk2(sacc[2 * kb][2], sacc[2 * kb][3]);
        if (2 * kb + 1 < 9) { pw.z = pk2(sacc[2 * kb + 1][0], sacc[2 * kb + 1][1]); pw.w = pk2(sacc[2 * kb + 1][2], sacc[2 * kb + 1][3]); } else { pw.z = 0u; pw.w = 0u; }
        const bf16x8 pf = __builtin_bit_cast(bf16x8, pw);
#pragma unroll
        for (int dt = 0; dt < 4; ++dt) { const LAS bf16* vp = Vb + dt * 16 * 200 + kb * 32;
            const u32x2 lo = *(const LAS u32x2*)vp; u32x2 hi = (u32x2){0u, 0u}; if (2 * kb + 1 < 9) hi = *(const LAS u32x2*)(vp + 16);
            u32x4 w; w.x = lo.x; w.y = lo.y; w.z = hi.x; w.w = hi.y; const bf16x8 vf = __builtin_bit_cast(bf16x8, w);
            oacc[dt] = __builtin_amdgcn_mfma_f32_16x16x32_bf16(vf, pf, oacc[dt], 0, 0, 0); }
        __builtin_amdgcn_sched_barrier(0);
    }
}
__device__ __forceinline__ void attn_phase(const Params& p, int layer, LAS unsigned char* lds, int tid) {
    OPQ_TID(tid);
    const bf16* PROJ = (const bf16*)(p.ws + WS_PROJ);
    bf16* YC = (bf16*)(p.ws + WS_Y + (size_t)M * 1024);
    LAS bf16* Ks = (LAS bf16*)lds;
    LAS bf16* Vt = (LAS bf16*)(lds + 27648);
    const int wave = tid >> 6, lane = tid & 63, l15 = lane & 15, quad = lane >> 4;
    const int g4 = wave >> 1, qh = wave & 1;
    constexpr int NQT = (L + 63) / 64;
    constexpr float LOG2E = 1.4426950408889634f;
    for (int item = blockIdx.x; item < BATCH * 2 * NQT; item += gridDim.x) {
        const int qt = item % NQT, bk = item / NQT, kvh = bk & 1, b = bk >> 1;
        const int t0 = qt * 64; const size_t mb = (size_t)b * L;
        __syncthreads();
#pragma unroll
        for (int i = 0; i < 3; ++i) { const int idx = tid + i * 512, row = idx >> 3, ch = idx & 7;
            int s = t0 - 128 + row; s = s < 0 ? 0 : (s > L - 1 ? L - 1 : s);
            const bf16* src = PROJ + (mb + s) * PC + 1792 + kvh * 64 + ch * 8;
            const u32x4 kv = *(const u32x4*)src; *(LAS u32x4*)(Ks + row * 72 + ch * 8) = kv;
            const u32x4 vv = *(const u32x4*)(src + 128);
            LAS bf16* vd = Vt + (ch * 8) * 200 + row;
            vd[0] = (bf16)(vv.x & 0xffffu); vd[200] = (bf16)(vv.x >> 16); vd[400] = (bf16)(vv.y & 0xffffu); vd[600] = (bf16)(vv.y >> 16);
            vd[800] = (bf16)(vv.z & 0xffffu); vd[1000] = (bf16)(vv.z >> 16); vd[1200] = (bf16)(vv.w & 0xffffu); vd[1400] = (bf16)(vv.w >> 16); }
        __syncthreads();
        const int hq = kvh * 4 + g4;
        const float slope2 = exp2f(-(float)(hq + 1)) * LOG2E, sink2 = INP(24)[layer * 8 + hq] * LOG2E;
#pragma unroll 1
        for (int ct = 0; ct < 2; ++ct) {
            const int kt0 = qh * 2 + ct;
            int tq = t0 + kt0 * 16 + l15; const int t = tq; tq = tq > L - 1 ? L - 1 : tq;
            bf16x8 qf[2];
#pragma unroll
            for (int ks = 0; ks < 2; ++ks) qf[ks] = *(const bf16x8*)(PROJ + (mb + tq) * PC + 1280 + hq * 64 + ks * 32 + quad * 8);
            const LAS bf16* Kb = Ks + (kt0 * 16 + l15) * 72 + quad * 8;
            const LAS bf16* Vb = Vt + l15 * 200 + kt0 * 16 + quad * 4;
            const float fd = (float)(l15 + 128 - quad * 4);
            f32x4 oacc[4]; float inv;
            if (t0 < 128) attn_ct<true>(Kb, Vb, qf, fd, quad * 4, l15, 128 - t0 - kt0 * 16, slope2, sink2, lane, oacc, inv);
            else attn_ct<false>(Kb, Vb, qf, fd, quad * 4, l15, 0, slope2, sink2, lane, oacc, inv);
            if (t < L) {
#pragma unroll
                for (int dt = 0; dt < 4; ++dt) st4bf(YC + (mb + t) * 512 + hq * 64 + dt * 16 + quad * 4, oacc[dt] * inv); }
        }
    }
}


#define XB_TMO      128
#define XB_XCNT(j)  (256  + 64 * (j))
#define XB_XSUB(j)  (1280 + 64 * (j))
#define XB_XGEN(j)  (2304 + 64 * (j))
#define XB_TOP      3328
#define XB_TOPGEN   3392
#define XCD_BAR_WORDS 3456
#define XB_SPIN_CAP (1u << 18)

__device__ __forceinline__ unsigned xb_ld(unsigned* p)              { return __hip_atomic_load(p, __ATOMIC_RELAXED, __HIP_MEMORY_SCOPE_AGENT); }
__device__ __forceinline__ unsigned xb_add(unsigned* p, unsigned v) { return __hip_atomic_fetch_add(p, v, __ATOMIC_RELAXED, __HIP_MEMORY_SCOPE_AGENT); }
__device__ __forceinline__ unsigned xb_xcc_id() { return (unsigned)__builtin_amdgcn_s_getreg((3 << 11) | 20) & 0xFu; }
#define XB_SPIN(cond, bar) do { unsigned _sp = 0; while (cond) { __builtin_amdgcn_s_sleep(1); \
    if ((++_sp & 255u) == 0u) { if (xb_ld(&(bar)[XB_TMO])) break; if (_sp > XB_SPIN_CAP) { atomicAdd(&(bar)[XB_TMO], 1u); break; } } } } while (0)

struct XcdBarrier {
    unsigned* bar; unsigned x;
    volatile LAS unsigned* st;
};

__device__ __forceinline__ XcdBarrier xcd_barrier_post(unsigned* bar, volatile LAS unsigned* st) {
    XcdBarrier b; b.bar = bar; b.x = xb_xcc_id(); b.st = st;
    if (threadIdx.x == 0) (void)xb_add(&bar[XB_XCNT(b.x)], 1u);
    return b;
}
__device__ __forceinline__ void xcd_barrier_complete(unsigned* bar, unsigned x, unsigned& nloc, unsigned& nx) {
    const unsigned G = gridDim.x * gridDim.y * gridDim.z;
    unsigned sum, cnt, mine, sp = 0u;
    for (;;) {
        sum = 0u; cnt = 0u; mine = 0u;
#pragma unroll
        for (unsigned j = 0; j < 16; ++j) { const unsigned c = xb_ld(&bar[XB_XCNT(j)]); sum += c; cnt += (c > 0u) ? 1u : 0u; mine = (j == x) ? c : mine; }
        if (sum == G) break;
        __builtin_amdgcn_s_sleep(1);
        if ((++sp & 255u) == 0u) { if (xb_ld(&bar[XB_TMO])) break; if (sp > XB_SPIN_CAP) { atomicAdd(&bar[XB_TMO], 1u); break; } }
    }
    nloc = mine > 0u ? mine : 1u; nx = cnt > 0u ? cnt : 1u;
}

__device__ __forceinline__ void xcd_barrier(const XcdBarrier& b) {
    asm volatile("s_waitcnt vmcnt(0)" ::: "memory");
    __syncthreads();
    if (threadIdx.x == 0) {
        unsigned* bar = b.bar;
        __builtin_amdgcn_s_waitcnt(0);
        unsigned nloc = b.st[0], nx = b.st[1];
        if (nloc == 0u) { xcd_barrier_complete(bar, b.x, nloc, nx); b.st[0] = nloc; b.st[1] = nx; }
        const unsigned old = xb_add(&bar[XB_XSUB(b.x)], 1u);
        const unsigned gen = old / nloc;
        if (old + 1u == (gen + 1u) * nloc) {
            __builtin_amdgcn_fence(__ATOMIC_RELEASE, "agent");
            asm volatile("s_waitcnt vmcnt(0)" ::: "memory");
            const unsigned og = xb_add(&bar[XB_TOP], 1u);
            const unsigned tg = og / nx;
            if (og + 1u == (tg + 1u) * nx) xb_add(&bar[XB_TOPGEN], 1u);
            else XB_SPIN(xb_ld(&bar[XB_TOPGEN]) == tg, bar);
            __builtin_amdgcn_fence(__ATOMIC_ACQUIRE, "agent");
            xb_add(&bar[XB_XGEN(b.x)], 1u);
            asm volatile("s_waitcnt vmcnt(0)" ::: "memory");
        } else {
            XB_SPIN(xb_ld(&bar[XB_XGEN(b.x)]) == gen, bar);
            __builtin_amdgcn_fence(__ATOMIC_ACQUIRE, "agent");
            asm volatile("s_waitcnt vmcnt(0)" ::: "memory");
        }
    }
    __syncthreads();
}

#ifndef REP_MASK
#define REP_MASK 0
#endif
#ifndef PMASK
#define PMASK 0xFFFF
#endif
#define EN(b) ((PMASK >> (b)) & 1)
__global__ void __launch_bounds__(512, 2) mega_fwd(Params p) {
    extern __shared__ __attribute__((aligned(16))) unsigned char lds_raw[];
    LAS unsigned char* lds = (LAS unsigned char*)lds_raw;
    XcdBarrier xbar; xbar.bar = nullptr; xbar.x = 0; xbar.st = nullptr;
    if (p.ph_hi - p.ph_lo > 1) {
        unsigned* barw = (unsigned*)(p.ws + WS_CTL + 65536);
        volatile LAS unsigned* MISC = (volatile LAS unsigned*)(lds + 131072 + 320);
        if (threadIdx.x < 64) MISC[threadIdx.x] = 0u;
        if (blockIdx.x == 0) for (int i = threadIdx.x; i < XCD_BAR_WORDS; i += 512) __hip_atomic_store(barw + i, 0u, __ATOMIC_RELAXED, __HIP_MEMORY_SCOPE_AGENT);
        __threadfence();
        cg::this_grid().sync();
        xbar = xcd_barrier_post(barw, MISC + 8);
    }
    for (int ph = p.ph_lo; ph < p.ph_hi; ++ph) {
        int tid = threadIdx.x; asm volatile("" : "+v"(tid));
        const int G = gridDim.x;
        unsigned char* ws = p.ws; asm volatile("" : "+s"(ws));
        bf16* Z = (bf16*)p.out;
        bf16* PROJ = (bf16*)(ws + WS_PROJ);
        unsigned char* wb = ws + WS_W;
        const int layer = ph / PER_LAYER, s = ph - layer * PER_LAYER;
        int nrep = 1;
        if (REP_MASK) {
            const int cls = (layer == DEPTH) ? 3 : (s == 5) ? 0 : (s == 1 || s == 3 || s == 11) ? 1 : (s == 2) ? 2 : (s == 0 || s == 10) ? 3 : (s == 6) ? 4 : 15;
            if ((REP_MASK >> cls) & 1) nrep = 2;
        }
        for (int rep = 0; rep < nrep; ++rep) {
        if (rep) __syncthreads();
        if (layer == DEPTH) {
            if (EN(0)) norm_phase<2>(p, INP(4), tid);
        } else if (s == 0) {
            if (EN(0)) { if (layer == 0) norm_phase<1>(p, INP(2), tid); else norm_phase<0>(p, INP(2) + layer * DM, tid); }
            if (EN(1)) convert_phase(p, layer, lds, tid);
        } else if (s == 10) {
            if (EN(0)) norm_phase<0>(p, INP(3) + layer * DM, tid);
        } else if (s == 2) {
            if (EN(2)) attn_phase(p, layer, lds, tid);
            if (EN(3)) prep1_phase(p, layer, tid);
        } else if (s == 4) {
            if (EN(4)) prep2_phase(p, layer, tid);
        } else if (s == 5) {
            if (EN(5)) scan_phase(p, layer, lds, tid);
        } else if (s == 6) {
            if (EN(6)) pool_phase(p, layer, lds, tid);
            if (EN(7) && rep == 0) post_phase(p, layer, tid);
        } else if (EN(8)) {
            const bf16* YB_ = (const bf16*)(ws + WS_Y);
            bf16* T3 = (bf16*)(ws + WS_SR);
            const int nsub = (s == 7) ? 4 : 1;
            for (int sub = 0; sub < nsub; ++sub) {
                pg8::Gemm g; pg8::EpiAny E{};
                if (s == 1) { g = pg8::Gemm{Z, (const bf16*)(wb + W_IN), M, 3072, 1024}; E.kind = 0; E.perm = true; E.st = pg8::EpiStore{PROJ, PC}; }
                else if (s == 3) { g = pg8::Gemm{YB_, (const bf16*)(wb + W_L), M, 1024, 512}; E.kind = 0; E.perm = true; E.st = pg8::EpiStore{PROJ, PC}; }
                else if (s == 7 && sub == 0) { g = pg8::Gemm{YB_, (const bf16*)(wb + W_BA), M, 1024, 256}; E.kind = 0; E.perm = true; E.st = pg8::EpiStore{PROJ, 1024}; }
                else if (s == 7 && sub == 1) { g = pg8::Gemm{YB_ + (size_t)M * 256, (const bf16*)(wb + W_BB), M, 1024, 256}; E.kind = 0; E.perm = true; E.st = pg8::EpiStore{PROJ + (size_t)M * 1024, 1024}; }
                else if (s == 7 && sub == 2) { g = pg8::Gemm{YB_ + (size_t)M * 512, (const bf16*)(wb + W_BC), M, 1024, 512}; E.kind = 0; E.perm = true; E.st = pg8::EpiStore{PROJ + (size_t)M * 2048, 1024}; }
                else if (s == 7) { g = pg8::Gemm{YB_ + (size_t)M * 1024, (const bf16*)(wb + W_BD), M, 1024, 256}; E.kind = 0; E.perm = true; E.st = pg8::EpiStore{T3, 1024}; }
                else if (s == 8) { g = pg8::Gemm{Z, (const bf16*)(wb + W_G), M, 4096, 1024}; E.kind = 1; E.perm = false;
                    E.gt = pg8::EpiGate4{PROJ, PROJ + (size_t)M * 1024, PROJ + (size_t)M * 2048, T3, PROJ}; }
                else if (s == 9) { g = pg8::Gemm{PROJ, (const bf16*)(wb + W_OUT), M, 1024, 1024}; E.kind = 2; E.perm = false; E.rs = pg8::EpiResid{(bf16*)(ws + WS_H)}; }
                else if (s == 12) { g = pg8::Gemm{PROJ, (const bf16*)(wb + W_DN), M, 1024, 2816}; E.kind = 2; E.perm = false; E.rs = pg8::EpiResid{(bf16*)(ws + WS_H)}; }
                else { g = pg8::Gemm{Z, (const bf16*)(wb + W_UP), M, 5632, 1024}; E.kind = 3; E.perm = false; E.sw = pg8::EpiSwiglu{PROJ}; }
                pg8::StaticOrder S; S.init(M, g.N, G, (int)((blockIdx.x + 64u * (unsigned)sub) % (unsigned)G));
                pg8::gemm_phase<pg8::EpiAny, pg8::StaticOrder, true, true>(lds, g, S, E);
            }
        }
        }
        if (ph + 1 < p.ph_hi) { xcd_barrier(xbar); if (REP_MASK & 32) xcd_barrier(xbar); }
    }
}

extern "C" void kernel_launch(void* const* d_in, const int* in_sizes, int n_in, void* d_out, int out_size, void* d_ws, size_t ws_size, hipStream_t stream) {
    static int grid = 0;
    if (grid == 0) {
        if (n_in != 29 || ws_size < WS_END) { fprintf(stderr, "kernel_launch: unexpected n_in %d or ws %zu (< %zu)\n", n_in, ws_size, (size_t)WS_END); grid = -1; return; }
        if (hipFuncSetAttribute((const void*)mega_fwd, hipFuncAttributeMaxDynamicSharedMemorySize, LDS_BYTES) != hipSuccess) { fprintf(stderr, "kernel_launch: hipFuncSetAttribute failed\n"); grid = -1; return; }
        int dev = 0, cus = 0, per_cu = 0;
        hipGetDevice(&dev); hipDeviceGetAttribute(&cus, hipDeviceAttributeMultiprocessorCount, dev);
        hipOccupancyMaxActiveBlocksPerMultiprocessor(&per_cu, (const void*)mega_fwd, 512, LDS_BYTES);
        (void)hipGetLastError();
        if (per_cu < 1) per_cu = 1;
        grid = cus > 0 ? cus : 256;
    }
    if (grid < 0) return;
    Params p{};
    for (int i = 0; i < 29; ++i) p.in[i] = (const float*)d_in[i];
    p.out = (float*)d_out; p.ws = (unsigned char*)d_ws;
#if SINGLE_LAUNCH
    p.ph_lo = 0; p.ph_hi = NPH;
    void* args[] = {&p};
    hipError_t e = hipLaunchCooperativeKernel((const void*)mega_fwd, dim3(grid), dim3(512), args, LDS_BYTES, stream);
    if (e != hipSuccess) fprintf(stderr, "cooperative launch failed: %s (grid %d)\n", hipGetErrorString(e), grid);
#else
    for (int ph = 0; ph < NPH; ++ph) { p.ph_lo = ph; p.ph_hi = ph + 1; hipLaunchKernelGGL(mega_fwd, dim3(grid), dim3(512), LDS_BYTES, stream, p); }
#endif
}
```

```cpp
#include <hip/hip_runtime.h>
#include <hip/hip_cooperative_groups.h>
#include <cstdio>
#include <cstdint>
namespace cg = cooperative_groups;

#ifndef SINGLE_LAUNCH
#define SINGLE_LAUNCH 1
#endif

namespace pg8 {
#define PG8_LAS __attribute__((address_space(3)))
typedef unsigned short bf16_t;
typedef short bf16x8 __attribute__((ext_vector_type(8)));
typedef float f32x4 __attribute__((ext_vector_type(4)));
typedef unsigned u32x4 __attribute__((ext_vector_type(4)));
constexpr int BM = 256, BK = 64, HALF = 128, HTB = HALF * BK * 2  , STAGE_BYTES = 8 * HTB, NXCD = 8, WGM = 8;

__host__ __device__ __forceinline__ int lds_byte(int r, int c) { const int st = (r >> 4) * 2 + (c >> 5), rr = r & 15, cc = c & 31, ob = rr * 64 + cc * 2; return st * 1024 + (ob ^ (((ob >> 9) & 1) << 5)); }
__host__ __device__ __forceinline__ void stage_rc(int b, int& R, int& C) { const int st = b / 1024, sb = b % 1024, swz = sb ^ (((sb >> 9) & 1) << 5); R = (st >> 1) * 16 + swz / 64; C = (st & 1) * 32 + (swz % 64) / 2; }
__host__ __device__ __forceinline__ int perm32(int rho) { const int n = rho >> 4, i = rho & 15; return 8 * (i >> 2) + 4 * n + (i & 3); }

struct Unit { int pm, pn; };
struct Gemm { const bf16_t* A; const bf16_t* Bt; int M, N, K; };

struct StaticOrder {
    int nM, nN, nwg, G, c, rev;
    __host__ __device__ void init(int M, int N, int G_, int c_) { nM = M / BM; nN = N / BM; nwg = nM * nN; G = G_; c = c_; rev = 0; }
    __host__ __device__ bool next(int i, Unit& u) const {
        const long L = (long)i * G + c; if (L >= nwg) return false;
        int wgid = (int)L; { const int q = nwg / NXCD, r = nwg % NXCD, xcd = wgid % NXCD, off = wgid / NXCD; wgid = (xcd < r ? xcd * (q + 1) : r * (q + 1) + (xcd - r) * q) + off; }
        const int nig = WGM * nN, gid = wgid / nig, fm = gid * WGM, gsz = (nM - fm) < WGM ? (nM - fm) : WGM;
        u.pm = fm + ((wgid % nig) % gsz); u.pn = (wgid % nig) / gsz; if (rev) u.pm = nM - 1 - u.pm; return true;
    }
    __device__ __forceinline__ void a_ready(const Unit&) const {}
    __device__ __forceinline__ void done(const Unit&) const {}
};
__device__ __forceinline__ unsigned cvt_pk_bf16(float lo, float hi) { unsigned r; asm volatile("v_cvt_pk_bf16_f32 %0, %1, %2" : "=v"(r) : "v"(lo), "v"(hi)); return r; }
typedef float f32x2 __attribute__((ext_vector_type(2)));
typedef unsigned u32x2 __attribute__((ext_vector_type(2)));
__device__ __forceinline__ float sigm_f(float x) { return __builtin_amdgcn_rcpf(1.0f + __expf(-x)); }
__device__ __forceinline__ float ebflo(unsigned w) { return __uint_as_float(w << 16); }
__device__ __forceinline__ float ebfhi(unsigned w) { return __uint_as_float(w & 0xffff0000u); }

struct EpiStore {
    static constexpr bool PERM = true, AFTER_DRAIN = false;
    bf16_t* O; int ldc;
    __device__ __forceinline__ void operator()(const f32x4 (&acc)[2][2][4][2], const Unit& u, int wr, int wc, int fr, int fq) const {
        const int row0 = u.pm * BM + wr * 64 + fr, col0 = u.pn * BM + wc * 32 + 8 * fq;
#pragma unroll
        for (int ai = 0; ai < 2; ++ai)
#pragma unroll
            for (int m = 0; m < 4; ++m) { bf16_t* rowp = O + (size_t)(row0 + ai * HALF + m * 16) * ldc + col0;
#pragma unroll
                for (int bj = 0; bj < 2; ++bj) { const f32x4 v0 = acc[ai][bj][m][0], v1 = acc[ai][bj][m][1];
                    u32x4 w; w.x = cvt_pk_bf16(v0[0], v0[1]); w.y = cvt_pk_bf16(v0[2], v0[3]); w.z = cvt_pk_bf16(v1[0], v1[1]); w.w = cvt_pk_bf16(v1[2], v1[3]);
                    *(u32x4*)(rowp + bj * HALF) = w; } }
    }
};
struct EpiResid {
    static constexpr bool PERM = false, AFTER_DRAIN = false;
    bf16_t* H;
    __device__ __forceinline__ void operator()(const f32x4 (&acc)[2][2][4][2], const Unit& u, int wr, int wc, int fr, int fq) const {
        const int row0 = u.pm * BM + wr * 64 + fr, col0 = u.pn * BM + wc * 32 + 4 * fq;
#pragma unroll
        for (int ai = 0; ai < 2; ++ai)
#pragma unroll
            for (int m = 0; m < 4; ++m) { bf16_t* rowp = H + (size_t)(row0 + ai * HALF + m * 16) * 1024 + col0;
#pragma unroll
                for (int bj = 0; bj < 2; ++bj)
#pragma unroll
                    for (int n = 0; n < 2; ++n) { u32x2* q = (u32x2*)(rowp + bj * HALF + n * 16); const u32x2 hv = *q; const f32x4 a = acc[ai][bj][m][n];
                        u32x2 w; w.x = cvt_pk_bf16(ebflo(hv.x) + a[0], ebfhi(hv.x) + a[1]); w.y = cvt_pk_bf16(ebflo(hv.y) + a[2], ebfhi(hv.y) + a[3]); *q = w; } }
    }
};
struct EpiSwiglu {
    static constexpr bool PERM = false, AFTER_DRAIN = false;
    bf16_t* ACT;
    __device__ __forceinline__ void operator()(const f32x4 (&acc)[2][2][4][2], const Unit& u, int wr, int wc, int fr, int fq) const {
        const int row0 = u.pm * BM + wr * 64 + fr, col0 = u.pn * 128 + wc * 16 + 4 * fq;
#pragma unroll
        for (int ai = 0; ai < 2; ++ai)
#pragma unroll
            for (int m = 0; m < 4; ++m) { bf16_t* rowp = ACT + (size_t)(row0 + ai * HALF + m * 16) * 2816 + col0;
#pragma unroll
                for (int bj = 0; bj < 2; ++bj) { const f32x4 g = acc[ai][bj][m][0], uu = acc[ai][bj][m][1];
                    u32x2 w; w.x = cvt_pk_bf16(g[0] * sigm_f(g[0]) * uu[0], g[1] * sigm_f(g[1]) * uu[1]); w.y = cvt_pk_bf16(g[2] * sigm_f(g[2]) * uu[2], g[3] * sigm_f(g[3]) * uu[3]);
                    *(u32x2*)(rowp + bj * 64) = w; } }
    }
};

struct EpiGate4 {
    static constexpr bool PERM = false, AFTER_DRAIN = false;
    const bf16_t* T0; const bf16_t* T1; const bf16_t* T2; const bf16_t* T3; bf16_t* MRG;
    __device__ __forceinline__ void operator()(const f32x4 (&acc)[2][2][4][2], const Unit& u, int wr, int wc, int fr, int fq) const {
        const int row0 = u.pm * BM + wr * 64 + fr, j0 = u.pn * 64 + wc * 16 + 4 * fq;
#pragma unroll
        for (int ai = 0; ai < 2; ++ai)
#pragma unroll
            for (int m = 0; m < 4; ++m) { const size_t off = (size_t)(row0 + ai * HALF + m * 16) * 1024 + j0;
                const u32x2 t0 = *(const u32x2*)(T0 + off), t1 = *(const u32x2*)(T1 + off), t2 = *(const u32x2*)(T2 + off), t3 = *(const u32x2*)(T3 + off);
                const f32x4 g0 = acc[ai][0][m][0], g1 = acc[ai][0][m][1], g2 = acc[ai][1][m][0], g3 = acc[ai][1][m][1];
                const float r0 = (sigm_f(g0[0]) * ebflo(t0.x) + sigm_f(g1[0]) * ebflo(t1.x)) + (sigm_f(g2[0]) * ebflo(t2.x) + sigm_f(g3[0]) * ebflo(t3.x));
                const float r1 = (sigm_f(g0[1]) * ebfhi(t0.x) + sigm_f(g1[1]) * ebfhi(t1.x)) + (sigm_f(g2[1]) * ebfhi(t2.x) + sigm_f(g3[1]) * ebfhi(t3.x));
                const float r2 = (sigm_f(g0[2]) * ebflo(t0.y) + sigm_f(g1[2]) * ebflo(t1.y)) + (sigm_f(g2[2]) * ebflo(t2.y) + sigm_f(g3[2]) * ebflo(t3.y));
                const float r3 = (sigm_f(g0[3]) * ebfhi(t0.y) + sigm_f(g1[3]) * ebfhi(t1.y)) + (sigm_f(g2[3]) * ebfhi(t2.y) + sigm_f(g3[3]) * ebfhi(t3.y));
                u32x2 w; w.x = cvt_pk_bf16(r0, r1); w.y = cvt_pk_bf16(r2, r3);
                *(u32x2*)(MRG + off) = w; }
    }
};

struct EpiAny {
    static constexpr bool AFTER_DRAIN = false;
    int kind; bool perm; EpiStore st; EpiGate4 gt; EpiResid rs; EpiSwiglu sw;
    __device__ __forceinline__ void operator()(const f32x4 (&acc)[2][2][4][2], const Unit& u, int wr, int wc, int fr, int fq) const {
        if (kind == 0) st(acc, u, wr, wc, fr, fq); else if (kind == 1) gt(acc, u, wr, wc, fr, fq); else if (kind == 2) rs(acc, u, wr, wc, fr, fq); else sw(acc, u, wr, wc, fr, fq);
    }
};

template <class Epi, class Sched, bool ALIGN_EPI = false, bool SP2 = false>
__device__ __forceinline__ void gemm_phase(PG8_LAS unsigned char* lds, const Gemm g, const Sched& S, const Epi& E) {
    int tid = threadIdx.x; asm volatile("" : "+v"(tid));
    const int wid = __builtin_amdgcn_readfirstlane(tid >> 6), lane = tid & 63, wr = wid >> 2, wc = wid & 3, fr = lane & 15, fq = lane >> 4;
    const int K = g.K, nt = K / BK;
    unsigned voffA[2], voffB[2];
#pragma unroll
    for (int i = 0; i < 2; ++i) { int R, C; stage_rc(tid * 16 + i * 8192, R, C); const int Rb = E.perm ? ((R & ~31) + perm32(R & 31)) : R;
        voffA[i] = (unsigned)(R * K + C) * 2u; voffB[i] = (unsigned)(Rb * K + C) * 2u; }
    const size_t kstep = (size_t)(BK * 2);
    const size_t hstep = (size_t)HALF * K * 2;
    const size_t tstep = 2 * hstep;
    const unsigned ldsw = (unsigned)wid * 1024u;
    const int aoff = lds_byte(wr * 64 + fr, fq * 8), boff = lds_byte(wc * 32 + fr, fq * 8);
#define PG8_SA(b, h) (((b) * 2 + (h)) * HTB)
#define PG8_SB(b, h) ((4 + (b) * 2 + (h)) * HTB)
#define PG8_STAGE(bufoff, gbase, voff) do { _Pragma("unroll") for (int _i = 0; _i < 2; ++_i) \
        __builtin_amdgcn_global_load_lds((const unsigned*)((const char*)(gbase) + (voff)[_i]), (PG8_LAS unsigned*)(lds + (bufoff) + ldsw + _i * 8192), 16, 0, 0); } while (0)
#define PG8_LDA(dst, b, h) do { _Pragma("unroll") for (int m = 0; m < 4; ++m) _Pragma("unroll") for (int k = 0; k < 2; ++k) dst[m][k] = *(const PG8_LAS bf16x8*)(lds + PG8_SA(b, h) + aoff + m * 2048 + k * 1024); } while (0)
#define PG8_LDB(dst, b, h) do { _Pragma("unroll") for (int n = 0; n < 2; ++n) _Pragma("unroll") for (int k = 0; k < 2; ++k) dst[n][k] = *(const PG8_LAS bf16x8*)(lds + PG8_SB(b, h) + boff + n * 2048 + k * 1024); } while (0)
#define PG8_MMA(ai, bj, At, Bt) do { __builtin_amdgcn_s_setprio(1); _Pragma("unroll") for (int m = 0; m < 4; ++m) _Pragma("unroll") for (int n = 0; n < 2; ++n) _Pragma("unroll") for (int k = 0; k < 2; ++k) \
        acc[ai][bj][m][n] = __builtin_amdgcn_mfma_f32_16x16x32_bf16(Bt[n][k], At[m][k], acc[ai][bj][m][n], 0, 0, 0); __builtin_amdgcn_s_setprio(0); } while (0)
#define PG8_WAIT_V(n) asm volatile("s_waitcnt vmcnt(" #n ")" ::: "memory")
#define PG8_WAIT_L(n) asm volatile("s_waitcnt lgkmcnt(" #n ")" ::: "memory")
#define PG8_BAR __builtin_amdgcn_s_barrier()
#define PG8_SCHED __builtin_amdgcn_sched_barrier(0)
    Unit cur, nxt; int ui = 0;
    if (!S.next(0, cur)) return;
    f32x4 acc[2][2][4][2];
#pragma unroll
    for (int a = 0; a < 2; ++a)
#pragma unroll
        for (int b = 0; b < 2; ++b)
#pragma unroll
            for (int m = 0; m < 4; ++m)
#pragma unroll
                for (int n = 0; n < 2; ++n) acc[a][b][m][n] = (f32x4){0.f, 0.f, 0.f, 0.f};
    bf16x8 At[4][2], B0[2][2], B1[2][2];
    const char* cA = (const char*)g.A + (size_t)cur.pm * tstep; const char* cB = (const char*)g.Bt + (size_t)cur.pn * tstep;
    S.a_ready(cur);
    if constexpr (SP2) {
        PG8_STAGE(PG8_SB(0, 0), cB, voffB); PG8_STAGE(PG8_SB(0, 1), cB + hstep, voffB); PG8_STAGE(PG8_SA(0, 0), cA, voffA); PG8_STAGE(PG8_SA(0, 1), cA + hstep, voffA);
        if (wr == 1) PG8_BAR;
        PG8_WAIT_V(2); PG8_BAR;
        PG8_STAGE(PG8_SB(1, 0), cB + kstep, voffB); PG8_STAGE(PG8_SA(1, 0), cA + kstep, voffA); PG8_STAGE(PG8_SB(1, 1), cB + hstep + kstep, voffB);
        PG8_WAIT_V(6); PG8_BAR;
    } else {
        PG8_STAGE(PG8_SB(0, 0), cB, voffB); PG8_STAGE(PG8_SA(0, 0), cA, voffA); PG8_STAGE(PG8_SB(0, 1), cB + hstep, voffB); PG8_STAGE(PG8_SA(0, 1), cA + hstep, voffA);
        if (wr == 1) PG8_BAR;
        PG8_WAIT_V(4); PG8_BAR;
        PG8_STAGE(PG8_SB(1, 0), cB + kstep, voffB); PG8_STAGE(PG8_SA(1, 0), cA + kstep, voffA); PG8_STAGE(PG8_SB(1, 1), cB + hstep + kstep, voffB);
        PG8_WAIT_V(6); PG8_BAR;
    }
    for (;;) {
        const bool has_next = S.next(ui + 1, nxt);
        const char* nA = has_next ? (const char*)g.A + (size_t)nxt.pm * tstep : cA; const char* nB = has_next ? (const char*)g.Bt + (size_t)nxt.pn * tstep : cB;
        for (int t = 0; t < nt; t += 2) {
            const bool last = (t == nt - 2);
            const char* a1 = cA + (size_t)(t + 1) * kstep;
            const char* a2 = last ? nA : cA + (size_t)(t + 2) * kstep; const char* b2 = last ? nB : cB + (size_t)(t + 2) * kstep;
            const char* a3 = a2 + kstep; const char* b3 = b2 + kstep;
            if (last && has_next) S.a_ready(nxt);
            if constexpr (SP2) {
            PG8_LDB(B0, 0, 0); PG8_LDB(B1, 0, 1); PG8_SCHED; PG8_LDA(At, 0, 0); PG8_STAGE(PG8_SA(1, 1), a1 + hstep, voffA);
            PG8_WAIT_V(8); PG8_WAIT_L(0); PG8_BAR; PG8_MMA(0, 0, At, B0); PG8_MMA(0, 1, At, B1); PG8_BAR; PG8_SCHED;
            PG8_LDA(At, 0, 1); PG8_STAGE(PG8_SB(0, 0), b2, voffB); PG8_STAGE(PG8_SB(0, 1), b2 + hstep, voffB); PG8_STAGE(PG8_SA(0, 0), a2, voffA);
            PG8_WAIT_V(8); PG8_WAIT_L(0); PG8_BAR; PG8_MMA(1, 0, At, B0); PG8_MMA(1, 1, At, B1); PG8_BAR; PG8_SCHED;
            PG8_LDB(B0, 1, 0); PG8_LDB(B1, 1, 1); PG8_SCHED; PG8_LDA(At, 1, 0); PG8_STAGE(PG8_SA(0, 1), a2 + hstep, voffA);
            PG8_WAIT_V(8); PG8_WAIT_L(0); PG8_BAR; PG8_MMA(0, 0, At, B0); PG8_MMA(0, 1, At, B1); PG8_BAR; PG8_SCHED;
            PG8_LDA(At, 1, 1); PG8_STAGE(PG8_SB(1, 0), b3, voffB); PG8_STAGE(PG8_SB(1, 1), b3 + hstep, voffB); PG8_STAGE(PG8_SA(1, 0), a3, voffA);
            PG8_WAIT_V(8); PG8_WAIT_L(0); PG8_BAR; PG8_MMA(1, 0, At, B0); PG8_MMA(1, 1, At, B1); PG8_BAR; PG8_SCHED;
            } else {
            PG8_LDB(B0, 0, 0); PG8_SCHED; PG8_LDA(At, 0, 0); PG8_STAGE(PG8_SA(1, 1), a1 + hstep, voffA);
            PG8_WAIT_L(8); PG8_BAR; PG8_WAIT_L(0); PG8_MMA(0, 0, At, B0); PG8_BAR; PG8_SCHED;
            PG8_LDB(B1, 0, 1); PG8_STAGE(PG8_SB(0, 0), b2, voffB);
            PG8_BAR; PG8_WAIT_L(0); PG8_MMA(0, 1, At, B1); PG8_BAR;
            PG8_LDA(At, 0, 1); PG8_STAGE(PG8_SA(0, 0), a2, voffA);
            PG8_BAR; PG8_WAIT_L(0); PG8_MMA(1, 0, At, B0); PG8_BAR; PG8_SCHED;
            PG8_STAGE(PG8_SB(0, 1), b2 + hstep, voffB);
            PG8_WAIT_V(6); PG8_BAR; PG8_MMA(1, 1, At, B1); PG8_BAR;
            PG8_LDB(B0, 1, 0); PG8_SCHED; PG8_LDA(At, 1, 0); PG8_STAGE(PG8_SA(0, 1), a2 + hstep, voffA);
            PG8_WAIT_L(8); PG8_BAR; PG8_WAIT_L(0); PG8_MMA(0, 0, At, B0); PG8_BAR; PG8_SCHED;
            PG8_LDB(B1, 1, 1); PG8_STAGE(PG8_SB(1, 0), b3, voffB);
            PG8_BAR; PG8_WAIT_L(0); PG8_MMA(0, 1, At, B1); PG8_BAR;
            PG8_LDA(At, 1, 1); PG8_STAGE(PG8_SA(1, 0), a3, voffA);
            PG8_BAR; PG8_WAIT_L(0); PG8_MMA(1, 0, At, B0); PG8_BAR; PG8_SCHED;
            PG8_STAGE(PG8_SB(1, 1), b3 + hstep, voffB);
            PG8_WAIT_V(6); PG8_BAR; PG8_MMA(1, 1, At, B1); PG8_BAR;
            }
        }
        if constexpr (ALIGN_EPI) { if (wr == 0) PG8_BAR; }
        if constexpr (!Epi::AFTER_DRAIN) { E(acc, cur, wr, wc, fr, fq); S.done(cur); }
        if (!has_next) break;
#pragma unroll
        for (int a = 0; a < 2; ++a)
#pragma unroll
            for (int b = 0; b < 2; ++b)
#pragma unroll
                for (int m = 0; m < 4; ++m)
#pragma unroll
                    for (int n = 0; n < 2; ++n) acc[a][b][m][n] = (f32x4){0.f, 0.f, 0.f, 0.f};
        cur = nxt; cA = nA; cB = nB; ++ui;
        if constexpr (ALIGN_EPI) { if (wr == 1) PG8_BAR; }
    }
    PG8_WAIT_V(0);
    if constexpr (!ALIGN_EPI) { if (wr == 0) PG8_BAR; }
    PG8_BAR;
    if constexpr (Epi::AFTER_DRAIN) { E.fused(acc, cur, wr, wc, fr, fq, lds, wid, lane); S.done(cur); }
#undef PG8_SA
#undef PG8_SB
#undef PG8_STAGE
#undef PG8_LDA
#undef PG8_LDB
#undef PG8_MMA
#undef PG8_WAIT_V
#undef PG8_WAIT_L
#undef PG8_BAR
#undef PG8_SCHED
}
}

#define LAS __attribute__((address_space(3)))
#define GAS __attribute__((address_space(1)))
typedef unsigned short bf16;
typedef float f32x4 __attribute__((ext_vector_type(4)));
typedef unsigned u32x4 __attribute__((ext_vector_type(4)));
typedef unsigned u32x2 __attribute__((ext_vector_type(2)));
typedef short bf16x8 __attribute__((ext_vector_type(8)));

constexpr int BATCH = 16, SEQ = 4096, NMETA = 16, L = SEQ + NMETA, M = BATCH * L, DM = 1024, DEPTH = 4, DFF = 2816, PC = 3072;
constexpr int PER_LAYER = 13, NPH = DEPTH * PER_LAYER + 1;
constexpr int LDS_BYTES = 147456;
static_assert(M % 256 == 0, "M tiles");

constexpr size_t WS_CTL = 0;
constexpr size_t WS_H = 1u << 20;
constexpr size_t WS_PROJ = WS_H + (size_t)M * DM * 4;
constexpr size_t WS_Y = WS_PROJ + (size_t)M * PC * 2;
constexpr size_t WS_W = WS_Y + (size_t)M * 1280 * 2;
constexpr size_t WS_VF = WS_W + (size_t)37748736;
constexpr size_t WS_SR = WS_VF + (size_t)M * 256 * 2;
constexpr size_t WS_SK = WS_SR + (size_t)M * 256 * 2;
constexpr size_t WS_SKK = WS_SK + (size_t)M * 256 * 2;
constexpr size_t W_IN = 0, W_G = W_IN + (size_t)3072 * 1024 * 2, W_BA = W_G + (size_t)4096 * 1024 * 2, W_BB = W_BA + 1024 * 256 * 2, W_BC = W_BB + 1024 * 256 * 2,
                 W_BD = W_BC + 1024 * 512 * 2, W_OUT = W_BD + 1024 * 256 * 2, W_UP = W_OUT + 1024 * 1024 * 2, W_DN = W_UP + (size_t)5632 * 1024 * 2, W_L = W_DN + (size_t)1024 * 2816 * 2,
                 W_END = W_L + 1024 * 512 * 2;
constexpr size_t WS_END = WS_SR + (size_t)M * 1024 * 2;
static_assert(W_END == 37748736 && WS_SKK + (size_t)M * 256 * 2 <= WS_END && WS_END <= (size_t)1073741824, "workspace map");
constexpr size_t OFF_T = 0, OFF_MRG = (size_t)M * 1024 * 2;

struct Params { const float* in[29]; float* out; unsigned char* ws; int ph_lo, ph_hi; };

__device__ __forceinline__ int opq(int i) { asm volatile("" : "+s"(i)); return i; }
#define INP(i) (p.in[opq(i)])
__device__ __forceinline__ float bflo(unsigned w) { return __uint_as_float(w << 16); }
__device__ __forceinline__ float bfhi(unsigned w) { return __uint_as_float(w & 0xffff0000u); }
__device__ __forceinline__ unsigned f2bf(float f) { unsigned u = __float_as_uint(f); return (u + 0x7fffu + ((u >> 16) & 1u)) >> 16; }
__device__ __forceinline__ unsigned pk2(float lo, float hi) { return f2bf(lo) | (f2bf(hi) << 16); }
__device__ __forceinline__ f32x4 up4bf(const u32x2 w) { return (f32x4){bflo(w.x), bfhi(w.x), bflo(w.y), bfhi(w.y)}; }
__device__ __forceinline__ f32x4 ld4bf(const bf16* p) { const u32x2 w = *(const u32x2*)p; return (f32x4){bflo(w.x), bfhi(w.x), bflo(w.y), bfhi(w.y)}; }
__device__ __forceinline__ void st4bf(bf16* p, f32x4 v) { u32x2 w; w.x = pk2(v.x, v.y); w.y = pk2(v.z, v.w); *(u32x2*)p = w; }
__device__ __forceinline__ float sigm(float x) { return __builtin_amdgcn_rcpf(1.0f + __expf(-x)); }
__device__ __forceinline__ float shx(float v, int o, int lane) { return __int_as_float(__builtin_amdgcn_ds_bpermute((lane ^ o) << 2, __float_as_int(v))); }
__device__ __forceinline__ float wave_sum(float v, int lane) {
#pragma unroll
    for (int o = 1; o < 64; o <<= 1) v += shx(v, o, lane);
    return v;
}
template <int CTRL> __device__ __forceinline__ float dppf(float x) { return __int_as_float(__builtin_amdgcn_mov_dpp(__float_as_int(x), CTRL, 0xF, 0xF, true)); }
__device__ __forceinline__ float row16_sum(float x) {
    x += dppf<0xB1>(x);
    x += dppf<0x4E>(x);
    x += dppf<0x141>(x);
    x += dppf<0x140>(x);
    return x;
}
#define OPQ_TID(tid) asm volatile("" : "+v"(tid))
#define WAVE_IDS(tid) const int lane = tid & 63, wave = __builtin_amdgcn_readfirstlane(tid >> 6), gw = blockIdx.x * 8 + wave, ngw = gridDim.x * 8; (void)lane; (void)wave; (void)gw; (void)ngw
#define LDS_WAIT() asm volatile("s_waitcnt lgkmcnt(0)" ::: "memory")

template <int MODE>
__device__ __forceinline__ void norm_phase(const Params& p, const float* gamma, int tid) {
    OPQ_TID(tid); WAVE_IDS(tid);
    bf16* H = (bf16*)(p.ws + WS_H);
    bf16* Z = (bf16*)p.out;
    f32x4 gv[4];
#pragma unroll
    for (int j = 0; j < 4; ++j) gv[j] = ((const f32x4*)gamma)[lane + 64 * j];
    for (int m0 = gw; m0 < M; m0 += 4 * ngw) {
        f32x4 vv[4][4];
#pragma unroll
        for (int q = 0; q < 4; ++q) { const int m = m0 + q * ngw;
            if (m < M) { const int b = m / L, t = m - b * L;
                if (MODE == 1) { const float* src = (t < NMETA) ? INP(1) + (size_t)t * DM : INP(0) + ((size_t)b * SEQ + (t - NMETA)) * DM;
#pragma unroll
                    for (int j = 0; j < 4; ++j) vv[q][j] = ((const f32x4*)src)[lane + 64 * j];
                } else {
#pragma unroll
                    for (int j = 0; j < 4; ++j) vv[q][j] = ld4bf(H + (size_t)m * DM + 4 * lane + 256 * j);
                } } }
#pragma unroll
        for (int q = 0; q < 4; ++q) { const int m = m0 + q * ngw;
            if (m < M) { const int b = m / L, t = m - b * L;
                f32x4 v[4]; float ss = 0.f;
#pragma unroll
                for (int j = 0; j < 4; ++j) { v[j] = vv[q][j]; ss += (v[j].x * v[j].x + v[j].y * v[j].y) + (v[j].z * v[j].z + v[j].w * v[j].w); }
                ss = wave_sum(ss, lane);
                const float rstd = rsqrtf(ss * (1.0f / DM) + 1e-6f);
                if (MODE == 1) {
#pragma unroll
                    for (int j = 0; j < 4; ++j) st4bf(H + (size_t)m * DM + 4 * lane + 256 * j, v[j]);
                }
                if (MODE == 2) {
                    if (t >= NMETA) { f32x4* o4 = (f32x4*)(p.out + ((size_t)b * SEQ + (t - NMETA)) * DM);
#pragma unroll
                        for (int j = 0; j < 4; ++j) o4[lane + 64 * j] = v[j] * rstd * gv[j]; }
                } else {
#pragma unroll
                    for (int j = 0; j < 4; ++j) st4bf(Z + (size_t)m * DM + 4 * lane + 256 * j, v[j] * rstd * gv[j]);
                }
            } }
    }
}

__device__ __forceinline__ void tr_item(const float* W, int N, int k0, int n0, bf16* D, int ld, int kd0, int nsub, int upmode, LAS float* scr, int lane) {
    float wv[32];
#pragma unroll
    for (int i = 0; i < 32; ++i) wv[i] = __builtin_nontemporal_load(W + (size_t)(k0 + 2 * i + (lane >> 5)) * N + n0 + (lane & 31));
#pragma unroll
    for (int i = 0; i < 32; ++i) scr[(2 * i + (lane >> 5)) * 33 + (lane & 31)] = wv[i];
    LDS_WAIT();
    const int c = lane & 7;
#pragma unroll
    for (int j = 0; j < 4; ++j) { const int n = (lane >> 3) + 8 * j; const LAS float* s = scr + (8 * c) * 33 + n;
        u32x4 o; o.x = pk2(s[0 * 33], s[1 * 33]); o.y = pk2(s[2 * 33], s[3 * 33]); o.z = pk2(s[4 * 33], s[5 * 33]); o.w = pk2(s[6 * 33], s[7 * 33]);
        const int ng = n0 + n; int dr;
        if (upmode == 1) { const int up = ng >= DFF ? 1 : 0, jj = ng - up * DFF; dr = (jj >> 4) * 32 + up * 16 + (jj & 15); }
        else if (upmode == 2) { const int bi = ng >> 10, jj = ng & 1023; dr = 256 * (jj >> 6) + 128 * (bi >> 1) + 32 * ((jj >> 4) & 3) + 16 * (bi & 1) + (jj & 15); }
        else dr = ng - nsub;
        *(u32x4*)(D + (size_t)dr * ld + kd0 + 8 * c) = o; }
    LDS_WAIT();
}
__device__ __forceinline__ void convert_phase(const Params& p, int layer, LAS unsigned char* lds, int tid) {
    OPQ_TID(tid); WAVE_IDS(tid);
    LAS float* scr = (LAS float*)(lds + wave * 16384);
    unsigned char* wb = p.ws + WS_W;
    constexpr int I_IN = 16 * 224, I_BR = 20 * 32, I_OUT = 16 * 32, I_UP = 16 * 176, I_DN = 44 * 32, NIT = I_IN + I_BR + I_OUT + I_UP + I_DN;
    const float* w_in = INP(5) + (size_t)layer * 1024 * 7168;
    const float* w_br = INP(6) + (size_t)layer * 1280 * 1024;
    const float* w_out = INP(7) + (size_t)layer * 1024 * 1024;
    const float* w_up = INP(27) + (size_t)layer * 1024 * 5632;
    const float* w_dn = INP(28) + (size_t)layer * 2816 * 1024;
    for (int it = gw; it < NIT; it += ngw) {
        int r = it;
        if (r < I_IN) { const int kb = r / 224, nb = r % 224, n0 = 32 * nb;
            if (n0 < 4096) tr_item(w_in, 7168, 64 * kb, n0, (bf16*)(wb + W_G), 1024, 64 * kb, 0, 2, scr, lane);
            else tr_item(w_in, 7168, 64 * kb, n0, (bf16*)(wb + W_IN), 1024, 64 * kb, 4096, 0, scr, lane);
            continue; }
        r -= I_IN;
        if (r < I_BR) { const int kb = r / 32, nb = r % 32, k0 = 64 * kb;
            if (kb < 4) tr_item(w_br, 1024, k0, 32 * nb, (bf16*)(wb + W_BA), 256, k0, 0, 0, scr, lane);
            else if (kb < 8) tr_item(w_br, 1024, k0, 32 * nb, (bf16*)(wb + W_BB), 256, k0 - 256, 0, 0, scr, lane);
            else if (kb < 16) tr_item(w_br, 1024, k0, 32 * nb, (bf16*)(wb + W_BC), 512, k0 - 512, 0, 0, scr, lane);
            else tr_item(w_br, 1024, k0, 32 * nb, (bf16*)(wb + W_BD), 256, k0 - 1024, 0, 0, scr, lane);
            continue; }
        r -= I_BR;
        if (r < I_OUT) { const int kb = r / 32, nb = r % 32; tr_item(w_out, 1024, 64 * kb, 32 * nb, (bf16*)(wb + W_OUT), 1024, 64 * kb, 0, 0, scr, lane); continue; }
        r -= I_OUT;
        if (r < I_UP) { const int kb = r / 176, nb = r % 176; tr_item(w_up, 5632, 64 * kb, 32 * nb, (bf16*)(wb + W_UP), 1024, 64 * kb, 0, 1, scr, lane); continue; }
        r -= I_UP;
        { const int kb = r / 32, nb = r % 32; tr_item(w_dn, 1024, 64 * kb, 32 * nb, (bf16*)(wb + W_DN), 2816, 64 * kb, 0, 0, scr, lane); }
    }
    {
        bf16* WL = (bf16*)(wb + W_L);
        const float* wup = INP(9) + (size_t)layer * 64 * 256;
        const float* aup = INP(11) + (size_t)layer * 64 * 256;
        const float* gup = INP(13) + (size_t)layer * 128 * 256;
        const float* vdn = INP(19) + (size_t)(layer > 0 ? layer - 1 : 0) * 256 * 32;
        const float* vup = INP(20) + (size_t)(layer > 0 ? layer - 1 : 0) * 32 * 256;
        const int nthr = gridDim.x * 512;
        for (int idx = blockIdx.x * 512 + tid; idx < 1024 * 512; idx += nthr) {
            const int n = idx >> 9, kx = idx & 511; float v = 0.f;
            if (n < 256) { if (kx < 64) v = wup[kx * 256 + n]; }
            else if (n < 512) { if (kx >= 64 && kx < 128) v = aup[(kx - 64) * 256 + (n - 256)]; }
            else if (n < 768) { if (kx >= 128 && kx < 256) v = gup[(kx - 128) * 256 + (n - 512)]; }
            else { if (kx >= 256 && layer > 0) { float s = 0.f;
#pragma unroll 8
                    for (int j = 0; j < 32; ++j) s += vdn[(kx - 256) * 32 + j] * vup[j * 256 + (n - 768)];
                    v = s; } }
            WL[idx] = (bf16)f2bf(v);
        }
    }
    if (layer == 0 && blockIdx.x == 0 && tid < 256) {
        const float* d = INP(25); float* LBT = (float*)(p.ws + WS_CTL + 4096);
        const float d0 = d[tid], d1 = d[256 + tid], d2 = d[512 + tid], d3 = d[768 + tid];
        const float mx = fmaxf(fmaxf(d0, d1), fmaxf(d2, d3));
        const float e0 = expf(d0 - mx), e1 = expf(d1 - mx), e2 = expf(d2 - mx), e3 = expf(d3 - mx);
        const float inv = 1.0f / (e0 + e1 + e2 + e3);
        LBT[tid] = 0.f; LBT[256 + tid] = e1 * inv; LBT[512 + tid] = (e1 + e2) * inv; LBT[768 + tid] = (e1 + e2 + e3) * inv;
    }
}

__device__ __forceinline__ void prep1_phase(const Params& p, int layer, int tid) {
    OPQ_TID(tid); WAVE_IDS(tid);
    const bf16* PROJ = (const bf16*)(p.ws + WS_PROJ);
    bf16* XV = (bf16*)(p.ws + WS_Y); bf16* SR = (bf16*)(p.ws + WS_SR); bf16* SK = (bf16*)(p.ws + WS_SK);
    const float* mu = INP(8) + (size_t)layer * 1024;
    f32x4 mu4[4];
#pragma unroll
    for (int s = 0; s < 4; ++s) mu4[s] = *(const f32x4*)(mu + s * 256 + 4 * lane);
    const int c4 = 4 * lane;
    for (int m0 = gw; m0 < M; m0 += 4 * ngw) {
        u32x2 ra[4][4], rb[4][4];
#pragma unroll
        for (int q = 0; q < 4; ++q) { const int m = m0 + q * ngw;
            if (m < M) { const int t = m % L; const bf16* cur = PROJ + (size_t)m * PC;
#pragma unroll
                for (int s = 0; s < 4; ++s) { ra[q][s] = *(const u32x2*)(cur + s * 256 + c4); rb[q][s] = (u32x2){0u, 0u}; if (t > 0) rb[q][s] = *(const u32x2*)(cur - PC + s * 256 + c4); } } }
#pragma unroll
        for (int q = 0; q < 4; ++q) { const int m = m0 + q * ngw;
            if (m < M) {
                f32x4 u[4];
#pragma unroll
                for (int s = 0; s < 4; ++s) { const f32x4 a = up4bf(ra[q][s]), b = up4bf(rb[q][s]); u[s] = a + (b - a) * mu4[s]; }
                st4bf(SR + (size_t)m * 256 + c4, u[0]);
                st4bf(SK + (size_t)m * 256 + c4, u[1]);
                st4bf(XV + (size_t)m * 512 + 256 + c4, u[2]);
                f32x4 x = u[3];
                if (c4 < 64) {
#pragma unroll
                    for (int e = 0; e < 4; ++e) { const float tt = __expf(2.0f * x[e]); x[e] = 1.0f - 2.0f * __builtin_amdgcn_rcpf(tt + 1.0f); }
                } else if (c4 >= 128) {
#pragma unroll
                    for (int e = 0; e < 4; ++e) x[e] = sigm(x[e]);
                }
                st4bf(XV + (size_t)m * 512 + c4, x);
            } }
    }
}

__device__ __forceinline__ void prep2_phase(const Params& p, int layer, int tid) {
    OPQ_TID(tid); WAVE_IDS(tid);
    bf16* PROJ = (bf16*)(p.ws + WS_PROJ);
    const bf16* XV = (const bf16*)(p.ws + WS_Y); bf16* SK = (bf16*)(p.ws + WS_SK); bf16* SKK = (bf16*)(p.ws + WS_SKK); bf16* VF = (bf16*)(p.ws + WS_VF);
    const int c4 = 4 * lane;
    const f32x4 w0 = *(const f32x4*)(INP(10) + layer * 256 + c4), a0 = *(const f32x4*)(INP(12) + layer * 256 + c4);
    const f32x4 kkw = *(const f32x4*)(INP(14) + layer * 256 + c4), kaw = *(const f32x4*)(INP(15) + layer * 256 + c4);
    f32x4 vr0 = (f32x4){0.f, 0.f, 0.f, 0.f};
    if (layer > 0) vr0 = *(const f32x4*)(INP(21) + (layer - 1) * 256 + c4);
    for (int m0 = gw; m0 < M; m0 += 4 * ngw) {
        u32x2 rw[4][6];
#pragma unroll
        for (int q = 0; q < 4; ++q) { const int m = m0 + q * ngw;
            if (m < M) { const bf16* pr = PROJ + (size_t)m * PC;
                rw[q][0] = *(const u32x2*)(pr + c4); rw[q][1] = *(const u32x2*)(pr + 256 + c4); rw[q][2] = *(const u32x2*)(pr + 768 + c4);
                rw[q][3] = *(const u32x2*)(XV + (size_t)m * 512 + 256 + c4); rw[q][4] = *(const u32x2*)(SK + (size_t)m * 256 + c4);
                rw[q][5] = (u32x2){0u, 0u}; if (layer > 0) rw[q][5] = *(const u32x2*)(VF + (size_t)m * 256 + c4); } }
#pragma unroll
        for (int q = 0; q < 4; ++q) { const int m = m0 + q * ngw;
            if (m < M) {
                bf16* pr = PROJ + (size_t)m * PC;
                const f32x4 wl = up4bf(rw[q][0]), al = up4bf(rw[q][1]), vr = up4bf(rw[q][2]), v = up4bf(rw[q][3]), k = up4bf(rw[q][4]);
                f32x4 lw, a, kkv, kn, vn;
                float ss = 0.f;
#pragma unroll
                for (int e = 0; e < 4; ++e) {
                    const float x = w0[e] + wl[e];
                    const float sp = fmaxf(-x, 0.f) + __logf(1.0f + __expf(-fabsf(x)));
                    lw[e] = -__expf(-sp - 0.5f);
                    a[e] = sigm(a0[e] + al[e]);
                    kkv[e] = k[e] * kkw[e]; ss += kkv[e] * kkv[e];
                    kn[e] = k[e] * (1.0f + (a[e] - 1.0f) * kaw[e]);
                }
                ss = row16_sum(ss);
                const float inv = 1.0f / fmaxf(sqrtf(ss), 1e-12f);
                if (layer > 0) { const f32x4 vf = up4bf(rw[q][5]);
#pragma unroll
                    for (int e = 0; e < 4; ++e) vn[e] = v[e] + (vf[e] - v[e]) * sigm(vr0[e] + vr[e]);
                } else { vn = v; st4bf(VF + (size_t)m * 256 + c4, v); }
                f32x4 kkn = kkv * inv;
                st4bf(pr + c4, lw);
                st4bf(pr + 256 + c4, kkn * a);
                st4bf(pr + 768 + c4, vn);
                st4bf(SK + (size_t)m * 256 + c4, kn);
                st4bf(SKK + (size_t)m * 256 + c4, kkn);
            } }
    }
}

__device__ __forceinline__ void scan_phase(const Params& p, int layer, LAS unsigned char* lds, int tid) {
    OPQ_TID(tid);
    typedef float f32x2 __attribute__((ext_vector_type(2)));
    const bf16* PROJ = (const bf16*)(p.ws + WS_PROJ);
    const bf16* SR = (const bf16*)(p.ws + WS_SR); const bf16* SK = (const bf16*)(p.ws + WS_SK); const bf16* SKK = (const bf16*)(p.ws + WS_SKK);
    bf16* YA = (bf16*)(p.ws + WS_Y); bf16* YD = (bf16*)(p.ws + WS_Y + (size_t)M * 2048);
    const float* LBT = (const float*)(p.ws + WS_CTL + 4096) + layer * 256;
    constexpr int O_RV = 5120, O_HW = 5376, O_HV = 7424, IN_F = 7680, OUT_F = 2048, O_HO = 1024;
    LAS float* INB = (LAS float*)lds;
    LAS float* OUTB = INB + 2 * IN_F;
    const int cw = tid >> 6, lane = tid & 63, kq = lane & 15, lt = tid & 127;
    const bool cR = cw < 4, cH = (cw == 4) || (cw == 5);
    const int rrow = cw * 4 + (lane >> 4);
    const int r0 = (cw & 1) * 8 + (lane >> 4) * 2;
    constexpr int NCH = L / 16;
    for (int item = blockIdx.x; item < 256; item += gridDim.x) {
        const int b = item >> 4, h = (item >> 2) & 3, rq = item & 3;
        const size_t mb = (size_t)b * L;
        const bf16* sp[8]; int sld[8], sk[8], sd[8];
        float lbv[8];
#pragma unroll
        for (int e = 0; e < 8; ++e) lbv[e] = 0.f;
#pragma unroll
        for (int i = 0; i < 8; ++i) {
            const int idx = lt + 128 * i; sp[i] = PROJ; sld[i] = 0; sk[i] = -1; sd[i] = 0;
            if (idx < 640) { const int vec = idx >> 7, rem = idx & 127, st = rem >> 3, ch = rem & 7; const int co = h * 64 + ch * 8;
                if (vec == 0) { sp[i] = SKK + (mb + st) * 256 + co; sld[i] = 256; } else if (vec == 1) { sp[i] = PROJ + (mb + st) * PC + co; sld[i] = PC; }
                else if (vec == 2) { sp[i] = PROJ + (mb + st) * PC + 256 + co; sld[i] = PC; } else if (vec == 3) { sp[i] = SK + (mb + st) * 256 + co; sld[i] = 256; }
                else { sp[i] = SR + (mb + st) * 256 + co; sld[i] = 256; }
                sk[i] = (vec == 1) ? 1 : 0; sd[i] = ((st * 16 + 2 * ch) * 5 + vec) * 4; }
            else if (idx < 672) { const int vi = idx - 640, st = vi >> 1, hf = vi & 1; sp[i] = PROJ + (mb + st) * PC + 768 + h * 64 + rq * 16 + hf * 8; sld[i] = PC; sk[i] = 2; sd[i] = O_RV + st * 16 + hf * 8; }
            else if (idx < 928) { const int j = idx - 672, st = (j & 127) >> 3, ch = j & 7;
                if (j < 128) { sp[i] = PROJ + (mb + st) * PC + 2048 + h * 64 + ch * 8; sk[i] = 3; sd[i] = O_HW + ((st * 16 + 2 * ch) * 2 + 1) * 4; }
                else { sp[i] = PROJ + (mb + st) * PC + 2304 + h * 64 + ch * 8; sk[i] = 4; sd[i] = O_HW + ((st * 16 + 2 * ch) * 2) * 4;
#pragma unroll
                    for (int e = 0; e < 8; ++e) lbv[e] = LBT[h * 64 + ch * 8 + e]; }
                sld[i] = PC; }
            else if (idx < 960) { const int vi = idx - 928, st = vi >> 1, hf = vi & 1; sp[i] = PROJ + (mb + st) * PC + 2560 + h * 64 + rq * 16 + hf * 8; sld[i] = PC; sk[i] = 2; sd[i] = O_HV + st * 16 + hf * 8; }
        }
        u32x4 preA[8], preB[8];
#pragma unroll
        for (int i = 0; i < 8; ++i) { preA[i] = (u32x4){0, 0, 0, 0}; preB[i] = (u32x4){0, 0, 0, 0}; }
#define SC_LOAD(P, chunk) do { _Pragma("unroll") for (int i = 0; i < 8; ++i) if (sk[i] >= 0) P[i] = *(const u32x4*)(sp[i] + (size_t)(chunk) * 16 * sld[i]); } while (0)
#define SC_ST4(off, a, b, c, d) *(LAS f32x4*)(dstb + (off)) = (f32x4){a, b, c, d}
#define SC_STAGE(P, dstb) do { _Pragma("unroll") for (int i = 0; i < 8; ++i) if (sk[i] >= 0) { \
            float f[8]; f[0] = bflo(P[i].x); f[1] = bfhi(P[i].x); f[2] = bflo(P[i].y); f[3] = bfhi(P[i].y); f[4] = bflo(P[i].z); f[5] = bfhi(P[i].z); f[6] = bflo(P[i].w); f[7] = bfhi(P[i].w); \
            const int o_ = sd[i]; \
            if (sk[i] == 0) { SC_ST4(o_, f[0], f[1], f[2], f[3]); SC_ST4(o_ + 20, f[4], f[5], f[6], f[7]); } \
            else if (sk[i] == 1) { _Pragma("unroll") for (int e = 0; e < 8; ++e) f[e] = __expf(f[e]); SC_ST4(o_, f[0], f[1], f[2], f[3]); SC_ST4(o_ + 20, f[4], f[5], f[6], f[7]); } \
            else if (sk[i] == 2) { SC_ST4(o_, f[0], f[1], f[2], f[3]); SC_ST4(o_ + 4, f[4], f[5], f[6], f[7]); } \
            else if (sk[i] == 3) { _Pragma("unroll") for (int e = 0; e < 8; ++e) f[e] = f[e] * sigm(f[e]); SC_ST4(o_, f[0], f[1], f[2], f[3]); SC_ST4(o_ + 8, f[4], f[5], f[6], f[7]); } \
            else { _Pragma("unroll") for (int e = 0; e < 8; ++e) f[e] = lbv[e] + (1.0f - lbv[e]) * sigm(f[e]); SC_ST4(o_, f[0], f[1], f[2], f[3]); SC_ST4(o_ + 8, f[4], f[5], f[6], f[7]); } } } while (0)
        if (!cR && !cH) { SC_LOAD(preA, 0); SC_LOAD(preB, 1); { LAS float* dstb = INB; SC_STAGE(preA, dstb); } SC_LOAD(preA, 2); }
        f32x2 S01 = (f32x2){0.f, 0.f}, S23 = S01;
        f32x2 H0 = (f32x2){0.f, 0.f}, H1 = H0, H2 = H0, H3 = H0;
        __syncthreads();
        for (int c = 0; c < NCH; ++c) {
            const int bi = c & 1;
            LAS float* inb = INB + bi * IN_F; LAS float* outb = OUTB + bi * OUT_F;
            if (cR) {
                const LAS float* RW = inb; const LAS float* RV = inb + O_RV; LAS float* RO = outb;
                const LAS f32x4* q = (const LAS f32x4*)(RW + kq * 20);
                f32x4 kk = q[0], w = q[1], bb = q[2], k = q[3], r = q[4]; float v = RV[rrow];
#pragma unroll
                for (int s = 0; s < 16; ++s) {
                    f32x4 nkk = kk, nw = w, nbb = bb, nk = k, nr = r; float nv = v;
                    if (s < 15) { const LAS f32x4* qn = (const LAS f32x4*)(RW + ((s + 1) * 16 + kq) * 20);
                        nkk = qn[0]; nw = qn[1]; nbb = qn[2]; nk = qn[3]; nr = qn[4]; nv = RV[(s + 1) * 16 + rrow]; }
                    const f32x2 p2 = S01 * kk.xy + S23 * kk.zw;
                    float pd = p2.x + p2.y;
                    const f32x2 a01 = S01 * w.xy + k.xy * v, a23 = S23 * w.zw + k.zw * v;
                    pd = row16_sum(pd);
                    S01 = a01 - bb.xy * pd; S23 = a23 - bb.zw * pd;
                    const f32x2 o2 = S01 * r.xy + S23 * r.zw;
                    float o = o2.x + o2.y;
                    o += dppf<0xB1>(o); o += dppf<0x4E>(o);
                    if ((kq & 3) == 0) RO[(s * 4 + (kq >> 2)) * 16 + rrow] = o;
                    kk = nkk; w = nw; bb = nbb; k = nk; r = nr; v = nv;
                }
            } else if (cH) {
                const LAS float* HW = inb + O_HW; const LAS float* HV = inb + O_HV; LAS float* HO = outb + O_HO;
                const LAS f32x4* q = (const LAS f32x4*)(HW + kq * 8);
                f32x4 f = q[0], qq = q[1]; f32x2 v2 = *(const LAS f32x2*)(HV + r0);
#pragma unroll
                for (int s = 0; s < 16; ++s) {
                    f32x4 nf = f, nqq = qq; f32x2 nv = v2;
                    if (s < 15) { const LAS f32x4* qn = (const LAS f32x4*)(HW + ((s + 1) * 16 + kq) * 8); nf = qn[0]; nqq = qn[1]; nv = *(const LAS f32x2*)(HV + (s + 1) * 16 + r0); }
                    H0 = v2 + (H0 - v2) * f.x; H1 = v2 + (H1 - v2) * f.y; H2 = v2 + (H2 - v2) * f.z; H3 = v2 + (H3 - v2) * f.w;
                    f32x2 o = (H0 * qq.x + H1 * qq.y) + (H2 * qq.z + H3 * qq.w);
                    o.x += dppf<0xB1>(o.x); o.y += dppf<0xB1>(o.y); o.x += dppf<0x4E>(o.x); o.y += dppf<0x4E>(o.y);
                    if ((kq & 3) == 0) *(LAS f32x2*)(HO + (s * 4 + (kq >> 2)) * 16 + r0) = o;
                    f = nf; qq = nqq; v2 = nv;
                }
            } else {
                if (c > 0) {
#pragma unroll
                    for (int i = 0; i < 2; ++i) { const int oi = lt + 128 * i;
                        const LAS float* po = OUTB + (bi ^ 1) * OUT_F + (oi >> 4) * 64 + (oi & 15);
                        const size_t mo = (mb + (size_t)(c - 1) * 16 + (oi >> 4)) * 256 + h * 64 + rq * 16 + (oi & 15);
                        YA[mo] = (bf16)f2bf((po[0] + po[16]) + (po[32] + po[48]));
                        YD[mo] = (bf16)f2bf((po[O_HO] + po[O_HO + 16]) + (po[O_HO + 32] + po[O_HO + 48])); }
                }
                if (c + 1 < NCH) {
                    if (bi == 0) { LAS float* dstb = INB + IN_F; SC_STAGE(preB, dstb); if (c + 3 < NCH) SC_LOAD(preB, c + 3); }
                    else { LAS float* dstb = INB; SC_STAGE(preA, dstb); if (c + 3 < NCH) SC_LOAD(preA, c + 3); }
                }
            }
            __syncthreads();
        }
        if (!cR && !cH) {
#pragma unroll
            for (int i = 0; i < 2; ++i) { const int oi = lt + 128 * i;
                const LAS float* po = OUTB + ((NCH - 1) & 1) * OUT_F + (oi >> 4) * 64 + (oi & 15);
                const size_t mo = (mb + (size_t)(NCH - 1) * 16 + (oi >> 4)) * 256 + h * 64 + rq * 16 + (oi & 15);
                YA[mo] = (bf16)f2bf((po[0] + po[16]) + (po[32] + po[48]));
                YD[mo] = (bf16)f2bf((po[O_HO] + po[O_HO + 16]) + (po[O_HO + 32] + po[O_HO + 48])); }
        }
        __syncthreads();
#undef SC_LOAD
#undef SC_ST4
#undef SC_STAGE
    }
}

__device__ __forceinline__ void post_phase(const Params& p, int layer, int tid) {
    OPQ_TID(tid); WAVE_IDS(tid);
    const bf16* PROJ = (const bf16*)(p.ws + WS_PROJ);
    const bf16* SR = (const bf16*)(p.ws + WS_SR); const bf16* SK = (const bf16*)(p.ws + WS_SK);
    bf16* YA = (bf16*)(p.ws + WS_Y); bf16* YD = (bf16*)(p.ws + WS_Y + (size_t)M * 2048);
    const int c4 = 4 * lane;
    const f32x4 lnw = *(const f32x4*)(INP(17) + layer * 256 + c4), lnb = *(const f32x4*)(INP(18) + layer * 256 + c4), rk = *(const f32x4*)(INP(16) + layer * 256 + c4);
    const f32x4 dn = *(const f32x4*)(INP(26) + layer * 256 + c4);
    for (int m0 = gw; m0 < M; m0 += 4 * ngw) {
        u32x2 rw[4][7];
#pragma unroll
        for (int q = 0; q < 4; ++q) { const int m = m0 + q * ngw;
            if (m < M) { const bf16* pr = PROJ + (size_t)m * PC;
                rw[q][0] = *(const u32x2*)(YA + (size_t)m * 256 + c4); rw[q][1] = *(const u32x2*)(SR + (size_t)m * 256 + c4); rw[q][2] = *(const u32x2*)(SK + (size_t)m * 256 + c4);
                rw[q][3] = *(const u32x2*)(pr + 768 + c4); rw[q][4] = *(const u32x2*)(pr + 512 + c4);
                rw[q][5] = *(const u32x2*)(YD + (size_t)m * 256 + c4); rw[q][6] = *(const u32x2*)(pr + 2816 + c4); } }
#pragma unroll
        for (int q = 0; q < 4; ++q) { const int m = m0 + q * ngw;
            if (m < M) {
                {
                    const f32x4 o = up4bf(rw[q][0]);
                    const float mean = row16_sum((o.x + o.y) + (o.z + o.w)) * (1.0f / 64.0f);
                    const f32x4 d = o - mean;
                    const float var = row16_sum((d.x * d.x + d.y * d.y) + (d.z * d.z + d.w * d.w)) * (1.0f / 64.0f);
                    const float rs = rsqrtf(var + 64e-5f);
                    const f32x4 r = up4bf(rw[q][1]), k = up4bf(rw[q][2]), v = up4bf(rw[q][3]), g = up4bf(rw[q][4]);
                    const f32x4 rkk = r * k * rk;
                    const float dot = row16_sum((rkk.x + rkk.y) + (rkk.z + rkk.w));
                    const f32x4 y = (d * rs * lnw + lnb + v * dot) * g;
                    st4bf(YA + (size_t)m * 256 + c4, y);
                }
                {
                    const f32x4 o = up4bf(rw[q][5]);
                    const float ms = row16_sum((o.x * o.x + o.y * o.y) + (o.z * o.z + o.w * o.w)) * (1.0f / 64.0f);
                    const float rs = rsqrtf(ms + 1e-6f);
                    const f32x4 g = up4bf(rw[q][6]);
                    f32x4 y;
#pragma unroll
                    for (int e = 0; e < 4; ++e) y[e] = o[e] * rs * dn[e] * (g[e] * sigm(g[e]));
                    st4bf(YD + (size_t)m * 256 + c4, y);
                }
            } }
    }
}

__device__ __forceinline__ void pool_phase(const Params& p, int layer, LAS unsigned char* lds, int tid) {
    OPQ_TID(tid);
    const bf16* PROJ = (const bf16*)(p.ws + WS_PROJ);
    bf16* YB = (bf16*)(p.ws + WS_Y + (size_t)M * 512);
    LAS float* U = (LAS float*)lds;
    LAS bf16* PB = (LAS bf16*)(lds + 48128);
    LAS bf16* MT = (LAS bf16*)(lds + 48128 + 16896);
    const float* mix = INP(22) + (size_t)layer * 4 * 64 * 64;
    const float* scale = INP(23) + layer * 256;
    const int wave = tid >> 6, lane = tid & 63, l15 = lane & 15, quad = lane >> 4;
    __syncthreads();
    for (int i = 0; i < 32; ++i) { const int idx = tid + 512 * i, g = idx >> 12, c = (idx >> 6) & 63, d = idx & 63; MT[(g * 64 + d) * 72 + c] = (bf16)f2bf(mix[idx] * scale[g * 64 + d]); }
    for (int tile = blockIdx.x; tile < M / 32; tile += gridDim.x) {
        const int m0 = tile * 32;
        __syncthreads();
#pragma unroll
        for (int i = 0; i < 3; ++i) { const int idx = tid + i * 512;
            if (idx < 47 * 32) { const int r = idx >> 5, ch = idx & 31, mm = m0 - 15 + r;
                u32x4 w = (u32x4){0, 0, 0, 0};
                if (mm >= 0) w = *(const u32x4*)(PROJ + (size_t)mm * PC + 1024 + ch * 8);
                LAS float* d = U + r * 256 + ch * 8;
                *(LAS f32x4*)d = (f32x4){bflo(w.x), bfhi(w.x), bflo(w.y), bfhi(w.y)}; *(LAS f32x4*)(d + 4) = (f32x4){bflo(w.z), bfhi(w.z), bflo(w.w), bfhi(w.w)}; } }
        __syncthreads();
        {
            const int c = tid & 255, rb = (tid >> 8) * 16, g = c >> 6, w = 2 << g; const float invw = 1.0f / (float)w;
            float sum = 0.f;
            for (int j = 0; j < w; ++j) sum += U[(15 + rb - j) * 256 + c];
            int t = (m0 + rb) % L;
            for (int i = 0; i < 16; ++i) {
                const int r = rb + i; const float cur = U[(15 + r) * 256 + c];
                if (i > 0) sum += cur - U[(15 + r - w) * 256 + c];
                float pv;
                if (t + 1 >= w) pv = sum * invw - cur;
                else { float s2 = 0.f; for (int j = 0; j <= t; ++j) s2 += U[(15 + r - j) * 256 + c]; pv = s2 / (float)(t + 1) - cur; }
                PB[r * 264 + c] = (bf16)f2bf(pv);
                t = (t + 1 == L) ? 0 : t + 1;
            }
        }
        __syncthreads();
        {
            const int g = wave >> 1, mt = wave & 1;
            bf16x8 a[2];
#pragma unroll
            for (int ks = 0; ks < 2; ++ks) a[ks] = *(const LAS bf16x8*)(PB + (mt * 16 + l15) * 264 + g * 64 + ks * 32 + quad * 8);
#pragma unroll
            for (int nt = 0; nt < 4; ++nt) {
                f32x4 acc = (f32x4){0.f, 0.f, 0.f, 0.f};
#pragma unroll
                for (int ks = 0; ks < 2; ++ks) { const bf16x8 bfr = *(const LAS bf16x8*)(MT + (g * 64 + nt * 16 + l15) * 72 + ks * 32 + quad * 8);
                    acc = __builtin_amdgcn_mfma_f32_16x16x32_bf16(a[ks], bfr, acc, 0, 0, 0); }
#pragma unroll
                for (int j = 0; j < 4; ++j) YB[(size_t)(m0 + mt * 16 + quad * 4 + j) * 256 + g * 64 + nt * 16 + l15] = (bf16)f2bf(acc[j]);
            }
        }
    }
}

template <bool EARLY>
__device__ __forceinline__ void attn_ct(const LAS bf16* Kb, const LAS bf16* Vb, const bf16x8 (&qf)[2], float fd, int rl, int l15, int smin, float slope2, float sink2, int lane, f32x4 (&oacc)[4], float& inv) {
    constexpr float LOG2E = 1.4426950408889634f;
    f32x4 sacc[9];
#pragma unroll
    for (int kk = 0; kk < 9; ++kk) sacc[kk] = (f32x4){0.f, 0.f, 0.f, 0.f};
#pragma unroll
    for (int kk = 0; kk < 9; ++kk)
#pragma unroll
        for (int ks = 0; ks < 2; ++ks) { const bf16x8 kf = *(const LAS bf16x8*)(Kb + kk * 16 * 72 + ks * 32);
            sacc[kk] = __builtin_amdgcn_mfma_f32_16x16x32_bf16(kf, qf[ks], sacc[kk], 0, 0, 0); if (ks == 1 && (kk & 1)) __builtin_amdgcn_sched_barrier(0); }
    float mx = -1e30f;
#pragma unroll
    for (int kk = 0; kk < 9; ++kk)
#pragma unroll
        for (int j = 0; j < 4; ++j) { const int rc = kk * 16 + j;
            float lg = sacc[kk][j] * (0.125f * LOG2E) - slope2 * (fd - (float)rc);
            if (kk == 0 || kk == 8 || EARLY) { bool ok = true;
                if (kk == 0) ok = (rc + rl) > l15;
                if (kk == 8) ok = (rc + rl) <= 128 + l15;
                if (EARLY) ok = ok && ((rc + rl) >= smin);
                lg = ok ? lg : -1e30f; }
            sacc[kk][j] = lg; mx = fmaxf(mx, lg); }
    mx = fmaxf(mx, shx(mx, 16, lane)); mx = fmaxf(mx, shx(mx, 32, lane)); mx = fmaxf(mx, sink2);
    float sum = 0.f;
#pragma unroll
    for (int kk = 0; kk < 9; ++kk)
#pragma unroll
        for (int j = 0; j < 4; ++j) { const float pe = __builtin_amdgcn_exp2f(sacc[kk][j] - mx); sacc[kk][j] = pe; sum += pe; }
    sum += shx(sum, 16, lane); sum += shx(sum, 32, lane); sum += __builtin_amdgcn_exp2f(sink2 - mx);
    inv = 1.0f / sum;
#pragma unroll
    for (int dt = 0; dt < 4; ++dt) oacc[dt] = (f32x4){0.f, 0.f, 0.f, 0.f};
#pragma unroll
    for (int kb = 0; kb < 5; ++kb) {
        u32x4 pw; pw.x = pk2(sacc[2 * kb][0], sacc[2 * kb][1]); pw.y = pk2(sacc[2 * kb][2], sacc[2 * kb][3]);
        if (2 * kb + 1 < 9) { pw.z = pk2(sacc[2 * kb + 1][0], sacc[2 * kb + 1][1]); pw.w = pk2(sacc[2 * kb + 1][2], sacc[2 * kb + 1][3]); } else { pw.z = 0u; pw.w = 0u; }
        const bf16x8 pf = __builtin_bit_cast(bf16x8, pw);
#pragma unroll
        for (int dt = 0; dt < 4; ++dt) { const LAS bf16* vp = Vb + dt * 16 * 200 + kb * 32;
            const u32x2 lo = *(const LAS u32x2*)vp; u32x2 hi = (u32x2){0u, 0u}; if (2 * kb + 1 < 9) hi = *(const LAS u32x2*)(vp + 16);
            u32x4 w; w.x = lo.x; w.y = lo.y; w.z = hi.x; w.w = hi.y; const bf16x8 vf = __builtin_bit_cast(bf16x8, w);
            oacc[dt] = __builtin_amdgcn_mfma_f32_16x16x32_bf16(vf, pf, oacc[dt], 0, 0, 0); }
        __builtin_amdgcn_sched_barrier(0);
    }
}
__device__ __forceinline__ void attn_phase(const Params& p, int layer, LAS unsigned char* lds, int tid) {
    OPQ_TID(tid);
    const bf16* PROJ = (const bf16*)(p.ws + WS_PROJ);
    bf16* YC = (bf16*)(p.ws + WS_Y + (size_t)M * 1024);
    LAS bf16* Ks = (LAS bf16*)lds;
    LAS bf16* Vt = (LAS bf16*)(lds + 27648);
    const int wave = tid >> 6, lane = tid & 63, l15 = lane & 15, quad = lane >> 4;
    const int g4 = wave >> 1, qh = wave & 1;
    constexpr int NQT = (L + 63) / 64;
    constexpr float LOG2E = 1.4426950408889634f;
    for (int item = blockIdx.x; item < BATCH * 2 * NQT; item += gridDim.x) {
        const int qt = item % NQT, bk = item / NQT, kvh = bk & 1, b = bk >> 1;
        const int t0 = qt * 64; const size_t mb = (size_t)b * L;
        __syncthreads();
#pragma unroll
        for (int i = 0; i < 3; ++i) { const int idx = tid + i * 512, row = idx >> 3, ch = idx & 7;
            int s = t0 - 128 + row; s = s < 0 ? 0 : (s > L - 1 ? L - 1 : s);
            const bf16* src = PROJ + (mb + s) * PC + 1792 + kvh * 64 + ch * 8;
            const u32x4 kv = *(const u32x4*)src; *(LAS u32x4*)(Ks + row * 72 + ch * 8) = kv;
            const u32x4 vv = *(const u32x4*)(src + 128);
            LAS bf16* vd = Vt + (ch * 8) * 200 + row;
            vd[0] = (bf16)(vv.x & 0xffffu); vd[200] = (bf16)(vv.x >> 16); vd[400] = (bf16)(vv.y & 0xffffu); vd[600] = (bf16)(vv.y >> 16);
            vd[800] = (bf16)(vv.z & 0xffffu); vd[1000] = (bf16)(vv.z >> 16); vd[1200] = (bf16)(vv.w & 0xffffu); vd[1400] = (bf16)(vv.w >> 16); }
        __syncthreads();
        const int hq = kvh * 4 + g4;
        const float slope2 = exp2f(-(float)(hq + 1)) * LOG2E, sink2 = INP(24)[layer * 8 + hq] * LOG2E;
#pragma unroll 1
        for (int ct = 0; ct < 2; ++ct) {
            const int kt0 = qh * 2 + ct;
            int tq = t0 + kt0 * 16 + l15; const int t = tq; tq = tq > L - 1 ? L - 1 : tq;
            bf16x8 qf[2];
#pragma unroll
            for (int ks = 0; ks < 2; ++ks) qf[ks] = *(const bf16x8*)(PROJ + (mb + tq) * PC + 1280 + hq * 64 + ks * 32 + quad * 8);
            const LAS bf16* Kb = Ks + (kt0 * 16 + l15) * 72 + quad * 8;
            const LAS bf16* Vb = Vt + l15 * 200 + kt0 * 16 + quad * 4;
            const float fd = (float)(l15 + 128 - quad * 4);
            f32x4 oacc[4]; float inv;
            if (t0 < 128) attn_ct<true>(Kb, Vb, qf, fd, quad * 4, l15, 128 - t0 - kt0 * 16, slope2, sink2, lane, oacc, inv);
            else attn_ct<false>(Kb, Vb, qf, fd, quad * 4, l15, 0, slope2, sink2, lane, oacc, inv);
            if (t < L) {
#pragma unroll
                for (int dt = 0; dt < 4; ++dt) st4bf(YC + (mb + t) * 512 + hq * 64 + dt * 16 + quad * 4, oacc[dt] * inv); }
        }
    }
}


#define XB_TMO      128
#define XB_XCNT(j)  (256  + 64 * (j))
#define XB_XSUB(j)  (1280 + 64 * (j))
#define XB_XGEN(j)  (2304 + 64 * (j))
#define XB_TOP      3328
#define XB_TOPGEN   3392
#define XCD_BAR_WORDS 3456
#define XB_SPIN_CAP (1u << 18)

__device__ __forceinline__ unsigned xb_ld(unsigned* p)              { return __hip_atomic_load(p, __ATOMIC_RELAXED, __HIP_MEMORY_SCOPE_AGENT); }
__device__ __forceinline__ unsigned xb_add(unsigned* p, unsigned v) { return __hip_atomic_fetch_add(p, v, __ATOMIC_RELAXED, __HIP_MEMORY_SCOPE_AGENT); }
__device__ __forceinline__ unsigned xb_xcc_id() { return (unsigned)__builtin_amdgcn_s_getreg((3 << 11) | 20) & 0xFu; }
#define XB_SPIN(cond, bar) do { unsigned _sp = 0; while (cond) { __builtin_amdgcn_s_sleep(1); \
    if ((++_sp & 255u) == 0u) { if (xb_ld(&(bar)[XB_TMO])) break; if (_sp > XB_SPIN_CAP) { atomicAdd(&(bar)[XB_TMO], 1u); break; } } } } while (0)

struct XcdBarrier {
    unsigned* bar; unsigned x;
    volatile LAS unsigned* st;
};

__device__ __forceinline__ XcdBarrier xcd_barrier_post(unsigned* bar, volatile LAS unsigned* st) {
    XcdBarrier b; b.bar = bar; b.x = xb_xcc_id(); b.st = st;
    if (threadIdx.x == 0) (void)xb_add(&bar[XB_XCNT(b.x)], 1u);
    return b;
}
__device__ __forceinline__ void xcd_barrier_complete(unsigned* bar, unsigned x, unsigned& nloc, unsigned& nx) {
    const unsigned G = gridDim.x * gridDim.y * gridDim.z;
    unsigned sum, cnt, mine, sp = 0u;
    for (;;) {
        sum = 0u; cnt = 0u; mine = 0u;
#pragma unroll
        for (unsigned j = 0; j < 16; ++j) { const unsigned c = xb_ld(&bar[XB_XCNT(j)]); sum += c; cnt += (c > 0u) ? 1u : 0u; mine = (j == x) ? c : mine; }
        if (sum == G) break;
        __builtin_amdgcn_s_sleep(1);
        if ((++sp & 255u) == 0u) { if (xb_ld(&bar[XB_TMO])) break; if (sp > XB_SPIN_CAP) { atomicAdd(&bar[XB_TMO], 1u); break; } }
    }
    nloc = mine > 0u ? mine : 1u; nx = cnt > 0u ? cnt : 1u;
}

__device__ __forceinline__ void xcd_barrier(const XcdBarrier& b) {
    asm volatile("s_waitcnt vmcnt(0)" ::: "memory");
    __syncthreads();
    if (threadIdx.x == 0) {
        unsigned* bar = b.bar;
        __builtin_amdgcn_s_waitcnt(0);
        unsigned nloc = b.st[0], nx = b.st[1];
        if (nloc == 0u) { xcd_barrier_complete(bar, b.x, nloc, nx); b.st[0] = nloc; b.st[1] = nx; }
        const unsigned old = xb_add(&bar[XB_XSUB(b.x)], 1u);
        const unsigned gen = old / nloc;
        if (old + 1u == (gen + 1u) * nloc) {
            __builtin_amdgcn_fence(__ATOMIC_RELEASE, "agent");
            asm volatile("s_waitcnt vmcnt(0)" ::: "memory");
            const unsigned og = xb_add(&bar[XB_TOP], 1u);
            const unsigned tg = og / nx;
            if (og + 1u == (tg + 1u) * nx) xb_add(&bar[XB_TOPGEN], 1u);
            else XB_SPIN(xb_ld(&bar[XB_TOPGEN]) == tg, bar);
            __builtin_amdgcn_fence(__ATOMIC_ACQUIRE, "agent");
            xb_add(&bar[XB_XGEN(b.x)], 1u);
            asm volatile("s_waitcnt vmcnt(0)" ::: "memory");
        } else {
            XB_SPIN(xb_ld(&bar[XB_XGEN(b.x)]) == gen, bar);
            __builtin_amdgcn_fence(__ATOMIC_ACQUIRE, "agent");
            asm volatile("s_waitcnt vmcnt(0)" ::: "memory");
        }
    }
    __syncthreads();
}

#ifndef REP_MASK
#define REP_MASK 0
#endif
#ifndef PMASK
#define PMASK 0xFFFF
#endif
#define EN(b) ((PMASK >> (b)) & 1)
__global__ void __launch_bounds__(512, 2) mega_fwd(Params p) {
    extern __shared__ __attribute__((aligned(16))) unsigned char lds_raw[];
    LAS unsigned char* lds = (LAS unsigned char*)lds_raw;
    XcdBarrier xbar; xbar.bar = nullptr; xbar.x = 0; xbar.st = nullptr;
    if (p.ph_hi - p.ph_lo > 1) {
        unsigned* barw = (unsigned*)(p.ws + WS_CTL + 65536);
        volatile LAS unsigned* MISC = (volatile LAS unsigned*)(lds + 131072 + 320);
        if (threadIdx.x < 64) MISC[threadIdx.x] = 0u;
        if (blockIdx.x == 0) for (int i = threadIdx.x; i < XCD_BAR_WORDS; i += 512) __hip_atomic_store(barw + i, 0u, __ATOMIC_RELAXED, __HIP_MEMORY_SCOPE_AGENT);
        __threadfence();
        cg::this_grid().sync();
        xbar = xcd_barrier_post(barw, MISC + 8);
    }
    for (int ph = p.ph_lo; ph < p.ph_hi; ++ph) {
        int tid = threadIdx.x; asm volatile("" : "+v"(tid));
        const int G = gridDim.x;
        unsigned char* ws = p.ws; asm volatile("" : "+s"(ws));
        bf16* Z = (bf16*)p.out;
        bf16* PROJ = (bf16*)(ws + WS_PROJ);
        unsigned char* wb = ws + WS_W;
        const int layer = ph / PER_LAYER, s = ph - layer * PER_LAYER;
        int nrep = 1;
        if (REP_MASK) {
            const int cls = (layer == DEPTH) ? 3 : (s == 5) ? 0 : (s == 1 || s == 3 || s == 11) ? 1 : (s == 2) ? 2 : (s == 0 || s == 10) ? 3 : (s == 6) ? 4 : 15;
            if ((REP_MASK >> cls) & 1) nrep = 2;
        }
        for (int rep = 0; rep < nrep; ++rep) {
        if (rep) __syncthreads();
        if (layer == DEPTH) {
            if (EN(0)) norm_phase<2>(p, INP(4), tid);
        } else if (s == 0) {
            if (EN(0)) { if (layer == 0) norm_phase<1>(p, INP(2), tid); else norm_phase<0>(p, INP(2) + layer * DM, tid); }
            if (EN(1)) convert_phase(p, layer, lds, tid);
        } else if (s == 10) {
            if (EN(0)) norm_phase<0>(p, INP(3) + layer * DM, tid);
        } else if (s == 2) {
            if (EN(2)) attn_phase(p, layer, lds, tid);
            if (EN(3)) prep1_phase(p, layer, tid);
        } else if (s == 4) {
            if (EN(4)) prep2_phase(p, layer, tid);
        } else if (s == 5) {
            if (EN(5)) scan_phase(p, layer, lds, tid);
        } else if (s == 6) {
            if (EN(6)) pool_phase(p, layer, lds, tid);
            if (EN(7) && rep == 0) post_phase(p, layer, tid);
        } else if (EN(8)) {
            const bf16* YB_ = (const bf16*)(ws + WS_Y);
            bf16* T3 = (bf16*)(ws + WS_SR);
            const int nsub = (s == 7) ? 4 : 1;
            for (int sub = 0; sub < nsub; ++sub) {
                pg8::Gemm g; pg8::EpiAny E{};
                if (s == 1) { g = pg8::Gemm{Z, (const bf16*)(wb + W_IN), M, 3072, 1024}; E.kind = 0; E.perm = true; E.st = pg8::EpiStore{PROJ, PC}; }
                else if (s == 3) { g = pg8::Gemm{YB_, (const bf16*)(wb + W_L), M, 1024, 512}; E.kind = 0; E.perm = true; E.st = pg8::EpiStore{PROJ, PC}; }
                else if (s == 7 && sub == 0) { g = pg8::Gemm{YB_, (const bf16*)(wb + W_BA), M, 1024, 256}; E.kind = 0; E.perm = true; E.st = pg8::EpiStore{PROJ, 1024}; }
                else if (s == 7 && sub == 1) { g = pg8::Gemm{YB_ + (size_t)M * 256, (const bf16*)(wb + W_BB), M, 1024, 256}; E.kind = 0; E.perm = true; E.st = pg8::EpiStore{PROJ + (size_t)M * 1024, 1024}; }
                else if (s == 7 && sub == 2) { g = pg8::Gemm{YB_ + (size_t)M * 512, (const bf16*)(wb + W_BC), M, 1024, 512}; E.kind = 0; E.perm = true; E.st = pg8::EpiStore{PROJ + (size_t)M * 2048, 1024}; }
                else if (s == 7) { g = pg8::Gemm{YB_ + (size_t)M * 1024, (const bf16*)(wb + W_BD), M, 1024, 256}; E.kind = 0; E.perm = true; E.st = pg8::EpiStore{T3, 1024}; }
                else if (s == 8) { g = pg8::Gemm{Z, (const bf16*)(wb + W_G), M, 4096, 1024}; E.kind = 1; E.perm = false;
                    E.gt = pg8::EpiGate4{PROJ, PROJ + (size_t)M * 1024, PROJ + (size_t)M * 2048, T3, PROJ}; }
                else if (s == 9) { g = pg8::Gemm{PROJ, (const bf16*)(wb + W_OUT), M, 1024, 1024}; E.kind = 2; E.perm = false; E.rs = pg8::EpiResid{(bf16*)(ws + WS_H)}; }
                else if (s == 12) { g = pg8::Gemm{PROJ, (const bf16*)(wb + W_DN), M, 1024, 2816}; E.kind = 2; E.perm = false; E.rs = pg8::EpiResid{(bf16*)(ws + WS_H)}; }
                else { g = pg8::Gemm{Z, (const bf16*)(wb + W_UP), M, 5632, 1024}; E.kind = 3; E.perm = false; E.sw = pg8::EpiSwiglu{PROJ}; }
                pg8::StaticOrder S; S.init(M, g.N, G, (int)((blockIdx.x + 64u * (unsigned)sub) % (unsigned)G)); S.rev = (s == 12) ? 1 : 0;
                pg8::gemm_phase<pg8::EpiAny, pg8::StaticOrder, true, true>(lds, g, S, E);
            }
        }
        }
        if (ph + 1 < p.ph_hi) { xcd_barrier(xbar); if (REP_MASK & 32) xcd_barrier(xbar); }
    }
}

extern "C" void kernel_launch(void* const* d_in, const int* in_sizes, int n_in, void* d_out, int out_size, void* d_ws, size_t ws_size, hipStream_t stream) {
    static int grid = 0;
    if (grid == 0) {
        if (n_in != 29 || ws_size < WS_END) { fprintf(stderr, "kernel_launch: unexpected n_in %d or ws %zu (< %zu)\n", n_in, ws_size, (size_t)WS_END); grid = -1; return; }
        if (hipFuncSetAttribute((const void*)mega_fwd, hipFuncAttributeMaxDynamicSharedMemorySize, LDS_BYTES) != hipSuccess) { fprintf(stderr, "kernel_launch: hipFuncSetAttribute failed\n"); grid = -1; return; }
        int dev = 0, cus = 0, per_cu = 0;
        hipGetDevice(&dev); hipDeviceGetAttribute(&cus, hipDeviceAttributeMultiprocessorCount, dev);
        hipOccupancyMaxActiveBlocksPerMultiprocessor(&per_cu, (const void*)mega_fwd, 512, LDS_BYTES);
        (void)hipGetLastError();
        if (per_cu < 1) per_cu = 1;
        grid = cus > 0 ? cus : 256;
    }
    if (grid < 0) return;
    Params p{};
    for (int i = 0; i < 29; ++i) p.in[i] = (const float*)d_in[i];
    p.out = (float*)d_out; p.ws = (unsigned char*)d_ws;
#if SINGLE_LAUNCH
    p.ph_lo = 0; p.ph_hi = NPH;
    void* args[] = {&p};
    hipError_t e = hipLaunchCooperativeKernel((const void*)mega_fwd, dim3(grid), dim3(512), args, LDS_BYTES, stream);
    if (e != hipSuccess) fprintf(stderr, "cooperative launch failed: %s (grid %d)\n", hipGetErrorString(e), grid);
#else
    for (int ph = 0; ph < NPH; ++ph) { p.ph_lo = ph; p.ph_hi = ph + 1; hipLaunchKernelGGL(mega_fwd, dim3(grid), dim3(512), LDS_BYTES, stream, p); }
#endif
}
```

```cpp
#include <hip/hip_runtime.h>
#include <hip/hip_cooperative_groups.h>
#include <cstdio>
#include <cstdint>
namespace cg = cooperative_groups;

#ifndef SINGLE_LAUNCH
#define SINGLE_LAUNCH 1
#endif

namespace pg8 {
#define PG8_LAS __attribute__((address_space(3)))
typedef unsigned short bf16_t;
typedef short bf16x8 __attribute__((ext_vector_type(8)));
typedef float f32x4 __attribute__((ext_vector_type(4)));
typedef unsigned u32x4 __attribute__((ext_vector_type(4)));
constexpr int BM = 256, BK = 64, HALF = 128, HTB = HALF * BK * 2  , STAGE_BYTES = 8 * HTB, NXCD = 8, WGM = 8;

__host__ __device__ __forceinline__ int lds_byte(int r, int c) { const int st = (r >> 4) * 2 + (c >> 5), rr = r & 15, cc = c & 31, ob = rr * 64 + cc * 2; return st * 1024 + (ob ^ (((ob >> 9) & 1) << 5)); }
__host__ __device__ __forceinline__ void stage_rc(int b, int& R, int& C) { const int st = b / 1024, sb = b % 1024, swz = sb ^ (((sb >> 9) & 1) << 5); R = (st >> 1) * 16 + swz / 64; C = (st & 1) * 32 + (swz % 64) / 2; }
__host__ __device__ __forceinline__ int perm32(int rho) { const int n = rho >> 4, i = rho & 15; return 8 * (i >> 2) + 4 * n + (i & 3); }

struct Unit { int pm, pn; };
struct Gemm { const bf16_t* A; const bf16_t* Bt; int M, N, K; };

struct StaticOrder {
    int nM, nN, nwg, G, c;
    __host__ __device__ void init(int M, int N, int G_, int c_) { nM = M / BM; nN = N / BM; nwg = nM * nN; G = G_; c = c_; }
    __host__ __device__ bool next(int i, Unit& u) const {
        const long L = (long)i * G + c; if (L >= nwg) return false;
        int wgid = (int)L; { const int q = nwg / NXCD, r = nwg % NXCD, xcd = wgid % NXCD, off = wgid / NXCD; wgid = (xcd < r ? xcd * (q + 1) : r * (q + 1) + (xcd - r) * q) + off; }
        const int nig = WGM * nN, gid = wgid / nig, fm = gid * WGM, gsz = (nM - fm) < WGM ? (nM - fm) : WGM;
        u.pm = fm + ((wgid % nig) % gsz); u.pn = (wgid % nig) / gsz; return true;
    }
    __device__ __forceinline__ void a_ready(const Unit&) const {}
    __device__ __forceinline__ void done(const Unit&) const {}
};
__device__ __forceinline__ unsigned cvt_pk_bf16(float lo, float hi) { unsigned r; asm volatile("v_cvt_pk_bf16_f32 %0, %1, %2" : "=v"(r) : "v"(lo), "v"(hi)); return r; }
typedef float f32x2 __attribute__((ext_vector_type(2)));
typedef unsigned u32x2 __attribute__((ext_vector_type(2)));
__device__ __forceinline__ float sigm_f(float x) { return __builtin_amdgcn_rcpf(1.0f + __expf(-x)); }
__device__ __forceinline__ float ebflo(unsigned w) { return __uint_as_float(w << 16); }
__device__ __forceinline__ float ebfhi(unsigned w) { return __uint_as_float(w & 0xffff0000u); }

struct EpiStore {
    static constexpr bool PERM = true, AFTER_DRAIN = false;
    bf16_t* O; int ldc;
    __device__ __forceinline__ void operator()(const f32x4 (&acc)[2][2][4][2], const Unit& u, int wr, int wc, int fr, int fq) const {
        const int row0 = u.pm * BM + wr * 64 + fr, col0 = u.pn * BM + wc * 32 + 8 * fq;
#pragma unroll
        for (int ai = 0; ai < 2; ++ai)
#pragma unroll
            for (int m = 0; m < 4; ++m) { bf16_t* rowp = O + (size_t)(row0 + ai * HALF + m * 16) * ldc + col0;
#pragma unroll
                for (int bj = 0; bj < 2; ++bj) { const f32x4 v0 = acc[ai][bj][m][0], v1 = acc[ai][bj][m][1];
                    u32x4 w; w.x = cvt_pk_bf16(v0[0], v0[1]); w.y = cvt_pk_bf16(v0[2], v0[3]); w.z = cvt_pk_bf16(v1[0], v1[1]); w.w = cvt_pk_bf16(v1[2], v1[3]);
                    *(u32x4*)(rowp + bj * HALF) = w; } }
    }
};
struct EpiResid {
    static constexpr bool PERM = false, AFTER_DRAIN = false;
    bf16_t* H;
    __device__ __forceinline__ void operator()(const f32x4 (&acc)[2][2][4][2], const Unit& u, int wr, int wc, int fr, int fq) const {
        const int row0 = u.pm * BM + wr * 64 + fr, col0 = u.pn * BM + wc * 32 + 4 * fq;
#pragma unroll
        for (int ai = 0; ai < 2; ++ai)
#pragma unroll
            for (int m = 0; m < 4; ++m) { bf16_t* rowp = H + (size_t)(row0 + ai * HALF + m * 16) * 1024 + col0;
#pragma unroll
                for (int bj = 0; bj < 2; ++bj)
#pragma unroll
                    for (int n = 0; n < 2; ++n) { u32x2* q = (u32x2*)(rowp + bj * HALF + n * 16); const u32x2 hv = *q; const f32x4 a = acc[ai][bj][m][n];
                        u32x2 w; w.x = cvt_pk_bf16(ebflo(hv.x) + a[0], ebfhi(hv.x) + a[1]); w.y = cvt_pk_bf16(ebflo(hv.y) + a[2], ebfhi(hv.y) + a[3]); *q = w; } }
    }
};
struct EpiSwiglu {
    static constexpr bool PERM = false, AFTER_DRAIN = false;
    bf16_t* ACT;
    __device__ __forceinline__ void operator()(const f32x4 (&acc)[2][2][4][2], const Unit& u, int wr, int wc, int fr, int fq) const {
        const int row0 = u.pm * BM + wr * 64 + fr, col0 = u.pn * 128 + wc * 16 + 4 * fq;
#pragma unroll
        for (int ai = 0; ai < 2; ++ai)
#pragma unroll
            for (int m = 0; m < 4; ++m) { bf16_t* rowp = ACT + (size_t)(row0 + ai * HALF + m * 16) * 2816 + col0;
#pragma unroll
                for (int bj = 0; bj < 2; ++bj) { const f32x4 g = acc[ai][bj][m][0], uu = acc[ai][bj][m][1];
                    u32x2 w; w.x = cvt_pk_bf16(g[0] * sigm_f(g[0]) * uu[0], g[1] * sigm_f(g[1]) * uu[1]); w.y = cvt_pk_bf16(g[2] * sigm_f(g[2]) * uu[2], g[3] * sigm_f(g[3]) * uu[3]);
                    *(u32x2*)(rowp + bj * 64) = w; } }
    }
};

struct EpiGate4 {
    static constexpr bool PERM = false, AFTER_DRAIN = false;
    const bf16_t* T0; const bf16_t* T1; const bf16_t* T2; const bf16_t* T3; bf16_t* MRG;
    __device__ __forceinline__ void operator()(const f32x4 (&acc)[2][2][4][2], const Unit& u, int wr, int wc, int fr, int fq) const {
        const int row0 = u.pm * BM + wr * 64 + fr, j0 = u.pn * 64 + wc * 16 + 4 * fq;
#pragma unroll
        for (int ai = 0; ai < 2; ++ai)
#pragma unroll
            for (int m = 0; m < 4; ++m) { const size_t off = (size_t)(row0 + ai * HALF + m * 16) * 1024 + j0;
                const u32x2 t0 = *(const u32x2*)(T0 + off), t1 = *(const u32x2*)(T1 + off), t2 = *(const u32x2*)(T2 + off), t3 = *(const u32x2*)(T3 + off);
                const f32x4 g0 = acc[ai][0][m][0], g1 = acc[ai][0][m][1], g2 = acc[ai][1][m][0], g3 = acc[ai][1][m][1];
                const float r0 = (sigm_f(g0[0]) * ebflo(t0.x) + sigm_f(g1[0]) * ebflo(t1.x)) + (sigm_f(g2[0]) * ebflo(t2.x) + sigm_f(g3[0]) * ebflo(t3.x));
                const float r1 = (sigm_f(g0[1]) * ebfhi(t0.x) + sigm_f(g1[1]) * ebfhi(t1.x)) + (sigm_f(g2[1]) * ebfhi(t2.x) + sigm_f(g3[1]) * ebfhi(t3.x));
                const float r2 = (sigm_f(g0[2]) * ebflo(t0.y) + sigm_f(g1[2]) * ebflo(t1.y)) + (sigm_f(g2[2]) * ebflo(t2.y) + sigm_f(g3[2]) * ebflo(t3.y));
                const float r3 = (sigm_f(g0[3]) * ebfhi(t0.y) + sigm_f(g1[3]) * ebfhi(t1.y)) + (sigm_f(g2[3]) * ebfhi(t2.y) + sigm_f(g3[3]) * ebfhi(t3.y));
                u32x2 w; w.x = cvt_pk_bf16(r0, r1); w.y = cvt_pk_bf16(r2, r3);
                *(u32x2*)(MRG + off) = w; }
    }
};

struct EpiAny {
    static constexpr bool AFTER_DRAIN = false;
    int kind; bool perm; EpiStore st; EpiGate4 gt; EpiResid rs; EpiSwiglu sw;
    __device__ __forceinline__ void operator()(const f32x4 (&acc)[2][2][4][2], const Unit& u, int wr, int wc, int fr, int fq) const {
        if (kind == 0) st(acc, u, wr, wc, fr, fq); else if (kind == 1) gt(acc, u, wr, wc, fr, fq); else if (kind == 2) rs(acc, u, wr, wc, fr, fq); else sw(acc, u, wr, wc, fr, fq);
    }
};

template <class Epi, class Sched, bool ALIGN_EPI = false, bool SP2 = false>
__device__ __forceinline__ void gemm_phase(PG8_LAS unsigned char* lds, const Gemm g, const Sched& S, const Epi& E) {
    int tid = threadIdx.x; asm volatile("" : "+v"(tid));
    const int wid = __builtin_amdgcn_readfirstlane(tid >> 6), lane = tid & 63, wr = wid >> 2, wc = wid & 3, fr = lane & 15, fq = lane >> 4;
    const int K = g.K, nt = K / BK;
    unsigned voffA[2], voffB[2];
#pragma unroll
    for (int i = 0; i < 2; ++i) { int R, C; stage_rc(tid * 16 + i * 8192, R, C); const int Rb = E.perm ? ((R & ~31) + perm32(R & 31)) : R;
        voffA[i] = (unsigned)(R * K + C) * 2u; voffB[i] = (unsigned)(Rb * K + C) * 2u; }
    const size_t kstep = (size_t)(BK * 2);
    const size_t hstep = (size_t)HALF * K * 2;
    const size_t tstep = 2 * hstep;
    const unsigned ldsw = (unsigned)wid * 1024u;
    const int aoff = lds_byte(wr * 64 + fr, fq * 8), boff = lds_byte(wc * 32 + fr, fq * 8);
#define PG8_SA(b, h) (((b) * 2 + (h)) * HTB)
#define PG8_SB(b, h) ((4 + (b) * 2 + (h)) * HTB)
#define PG8_STAGE(bufoff, gbase, voff) do { _Pragma("unroll") for (int _i = 0; _i < 2; ++_i) \
        __builtin_amdgcn_global_load_lds((const unsigned*)((const char*)(gbase) + (voff)[_i]), (PG8_LAS unsigned*)(lds + (bufoff) + ldsw + _i * 8192), 16, 0, 0); } while (0)
#define PG8_LDA(dst, b, h) do { _Pragma("unroll") for (int m = 0; m < 4; ++m) _Pragma("unroll") for (int k = 0; k < 2; ++k) dst[m][k] = *(const PG8_LAS bf16x8*)(lds + PG8_SA(b, h) + aoff + m * 2048 + k * 1024); } while (0)
#define PG8_LDB(dst, b, h) do { _Pragma("unroll") for (int n = 0; n < 2; ++n) _Pragma("unroll") for (int k = 0; k < 2; ++k) dst[n][k] = *(const PG8_LAS bf16x8*)(lds + PG8_SB(b, h) + boff + n * 2048 + k * 1024); } while (0)
#define PG8_MMA(ai, bj, At, Bt) do { __builtin_amdgcn_s_setprio(1); _Pragma("unroll") for (int m = 0; m < 4; ++m) _Pragma("unroll") for (int n = 0; n < 2; ++n) _Pragma("unroll") for (int k = 0; k < 2; ++k) \
        acc[ai][bj][m][n] = __builtin_amdgcn_mfma_f32_16x16x32_bf16(Bt[n][k], At[m][k], acc[ai][bj][m][n], 0, 0, 0); __builtin_amdgcn_s_setprio(0); } while (0)
#define PG8_WAIT_V(n) asm volatile("s_waitcnt vmcnt(" #n ")" ::: "memory")
#define PG8_WAIT_L(n) asm volatile("s_waitcnt lgkmcnt(" #n ")" ::: "memory")
#define PG8_BAR __builtin_amdgcn_s_barrier()
#define PG8_SCHED __builtin_amdgcn_sched_barrier(0)
    Unit cur, nxt; int ui = 0;
    if (!S.next(0, cur)) return;
    f32x4 acc[2][2][4][2];
#pragma unroll
    for (int a = 0; a < 2; ++a)
#pragma unroll
        for (int b = 0; b < 2; ++b)
#pragma unroll
            for (int m = 0; m < 4; ++m)
#pragma unroll
                for (int n = 0; n < 2; ++n) acc[a][b][m][n] = (f32x4){0.f, 0.f, 0.f, 0.f};
    bf16x8 At[4][2], B0[2][2], B1[2][2];
    const char* cA = (const char*)g.A + (size_t)cur.pm * tstep; const char* cB = (const char*)g.Bt + (size_t)cur.pn * tstep;
    S.a_ready(cur);
    if constexpr (SP2) {
        PG8_STAGE(PG8_SB(0, 0), cB, voffB); PG8_STAGE(PG8_SB(0, 1), cB + hstep, voffB); PG8_STAGE(PG8_SA(0, 0), cA, voffA); PG8_STAGE(PG8_SA(0, 1), cA + hstep, voffA);
        if (wr == 1) PG8_BAR;
        PG8_WAIT_V(2); PG8_BAR;
        PG8_STAGE(PG8_SB(1, 0), cB + kstep, voffB); PG8_STAGE(PG8_SA(1, 0), cA + kstep, voffA); PG8_STAGE(PG8_SB(1, 1), cB + hstep + kstep, voffB);
        PG8_WAIT_V(6); PG8_BAR;
    } else {
        PG8_STAGE(PG8_SB(0, 0), cB, voffB); PG8_STAGE(PG8_SA(0, 0), cA, voffA); PG8_STAGE(PG8_SB(0, 1), cB + hstep, voffB); PG8_STAGE(PG8_SA(0, 1), cA + hstep, voffA);
        if (wr == 1) PG8_BAR;
        PG8_WAIT_V(4); PG8_BAR;
        PG8_STAGE(PG8_SB(1, 0), cB + kstep, voffB); PG8_STAGE(PG8_SA(1, 0), cA + kstep, voffA); PG8_STAGE(PG8_SB(1, 1), cB + hstep + kstep, voffB);
        PG8_WAIT_V(6); PG8_BAR;
    }
    for (;;) {
        const bool has_next = S.next(ui + 1, nxt);
        const char* nA = has_next ? (const char*)g.A + (size_t)nxt.pm * tstep : cA; const char* nB = has_next ? (const char*)g.Bt + (size_t)nxt.pn * tstep : cB;
        for (int t = 0; t < nt; t += 2) {
            const bool last = (t == nt - 2);
            const char* a1 = cA + (size_t)(t + 1) * kstep;
            const char* a2 = last ? nA : cA + (size_t)(t + 2) * kstep; const char* b2 = last ? nB : cB + (size_t)(t + 2) * kstep;
            const char* a3 = a2 + kstep; const char* b3 = b2 + kstep;
            if (last && has_next) S.a_ready(nxt);
            if constexpr (SP2) {
            PG8_LDB(B0, 0, 0); PG8_LDB(B1, 0, 1); PG8_SCHED; PG8_LDA(At, 0, 0); PG8_STAGE(PG8_SA(1, 1), a1 + hstep, voffA);
            PG8_WAIT_V(8); PG8_WAIT_L(0); PG8_BAR; PG8_MMA(0, 0, At, B0); PG8_MMA(0, 1, At, B1); PG8_BAR; PG8_SCHED;
            PG8_LDA(At, 0, 1); PG8_STAGE(PG8_SB(0, 0), b2, voffB); PG8_STAGE(PG8_SB(0, 1), b2 + hstep, voffB); PG8_STAGE(PG8_SA(0, 0), a2, voffA);
            PG8_WAIT_V(8); PG8_WAIT_L(0); PG8_BAR; PG8_MMA(1, 0, At, B0); PG8_MMA(1, 1, At, B1); PG8_BAR; PG8_SCHED;
            PG8_LDB(B0, 1, 0); PG8_LDB(B1, 1, 1); PG8_SCHED; PG8_LDA(At, 1, 0); PG8_STAGE(PG8_SA(0, 1), a2 + hstep, voffA);
            PG8_WAIT_V(8); PG8_WAIT_L(0); PG8_BAR; PG8_MMA(0, 0, At, B0); PG8_MMA(0, 1, At, B1); PG8_BAR; PG8_SCHED;
            PG8_LDA(At, 1, 1); PG8_STAGE(PG8_SB(1, 0), b3, voffB); PG8_STAGE(PG8_SB(1, 1), b3 + hstep, voffB); PG8_STAGE(PG8_SA(1, 0), a3, voffA);
            PG8_WAIT_V(8); PG8_WAIT_L(0); PG8_BAR; PG8_MMA(1, 0, At, B0); PG8_MMA(1, 1, At, B1); PG8_BAR; PG8_SCHED;
            } else {
            PG8_LDB(B0, 0, 0); PG8_SCHED; PG8_LDA(At, 0, 0); PG8_STAGE(PG8_SA(1, 1), a1 + hstep, voffA);
            PG8_WAIT_L(8); PG8_BAR; PG8_WAIT_L(0); PG8_MMA(0, 0, At, B0); PG8_BAR; PG8_SCHED;
            PG8_LDB(B1, 0, 1); PG8_STAGE(PG8_SB(0, 0), b2, voffB);
            PG8_BAR; PG8_WAIT_L(0); PG8_MMA(0, 1, At, B1); PG8_BAR;
            PG8_LDA(At, 0, 1); PG8_STAGE(PG8_SA(0, 0), a2, voffA);
            PG8_BAR; PG8_WAIT_L(0); PG8_MMA(1, 0, At, B0); PG8_BAR; PG8_SCHED;
            PG8_STAGE(PG8_SB(0, 1), b2 + hstep, voffB);
            PG8_WAIT_V(6); PG8_BAR; PG8_MMA(1, 1, At, B1); PG8_BAR;
            PG8_LDB(B0, 1, 0); PG8_SCHED; PG8_LDA(At, 1, 0); PG8_STAGE(PG8_SA(0, 1), a2 + hstep, voffA);
            PG8_WAIT_L(8); PG8_BAR; PG8_WAIT_L(0); PG8_MMA(0, 0, At, B0); PG8_BAR; PG8_SCHED;
            PG8_LDB(B1, 1, 1); PG8_STAGE(PG8_SB(1, 0), b3, voffB);
            PG8_BAR; PG8_WAIT_L(0); PG8_MMA(0, 1, At, B1); PG8_BAR;
            PG8_LDA(At, 1, 1); PG8_STAGE(PG8_SA(1, 0), a3, voffA);
            PG8_BAR; PG8_WAIT_L(0); PG8_MMA(1, 0, At, B0); PG8_BAR; PG8_SCHED;
            PG8_STAGE(PG8_SB(1, 1), b3 + hstep, voffB);
            PG8_WAIT_V(6); PG8_BAR; PG8_MMA(1, 1, At, B1); PG8_BAR;
            }
        }
        if constexpr (ALIGN_EPI) { if (wr == 0) PG8_BAR; }
        if constexpr (!Epi::AFTER_DRAIN) { E(acc, cur, wr, wc, fr, fq); S.done(cur); }
        if (!has_next) break;
#pragma unroll
        for (int a = 0; a < 2; ++a)
#pragma unroll
            for (int b = 0; b < 2; ++b)
#pragma unroll
                for (int m = 0; m < 4; ++m)
#pragma unroll
                    for (int n = 0; n < 2; ++n) acc[a][b][m][n] = (f32x4){0.f, 0.f, 0.f, 0.f};
        cur = nxt; cA = nA; cB = nB; ++ui;
        if constexpr (ALIGN_EPI) { if (wr == 1) PG8_BAR; }
    }
    PG8_WAIT_V(0);
    if constexpr (!ALIGN_EPI) { if (wr == 0) PG8_BAR; }
    PG8_BAR;
    if constexpr (Epi::AFTER_DRAIN) { E.fused(acc, cur, wr, wc, fr, fq, lds, wid, lane); S.done(cur); }
#undef PG8_SA
#undef PG8_SB
#undef PG8_STAGE
#undef PG8_LDA
#undef PG8_LDB
#undef PG8_MMA
#undef PG8_WAIT_V
#undef PG8_WAIT_L
#undef PG8_BAR
#undef PG8_SCHED
}
}

#define LAS __attribute__((address_space(3)))
#define GAS __attribute__((address_space(1)))
typedef unsigned short bf16;
typedef float f32x4 __attribute__((ext_vector_type(4)));
typedef unsigned u32x4 __attribute__((ext_vector_type(4)));
typedef unsigned u32x2 __attribute__((ext_vector_type(2)));
typedef short bf16x8 __attribute__((ext_vector_type(8)));

constexpr int BATCH = 16, SEQ = 4096, NMETA = 16, L = SEQ + NMETA, M = BATCH * L, DM = 1024, DEPTH = 4, DFF = 2816, PC = 3072;
constexpr int PER_LAYER = 13, NPH = DEPTH * PER_LAYER + 1;
constexpr int LDS_BYTES = 147456;
static_assert(M % 256 == 0, "M tiles");

constexpr size_t WS_CTL = 0;
constexpr size_t WS_H = 1u << 20;
constexpr size_t WS_PROJ = WS_H + (size_t)M * DM * 4;
constexpr size_t WS_Y = WS_PROJ + (size_t)M * PC * 2;
constexpr size_t WS_W = WS_Y + (size_t)M * 1280 * 2;
constexpr size_t WS_VF = WS_W + (size_t)37748736;
constexpr size_t WS_SR = WS_VF + (size_t)M * 256 * 2;
constexpr size_t WS_SK = WS_SR + (size_t)M * 256 * 2;
constexpr size_t WS_SKK = WS_SK + (size_t)M * 256 * 2;
constexpr size_t W_IN = 0, W_G = W_IN + (size_t)3072 * 1024 * 2, W_BA = W_G + (size_t)4096 * 1024 * 2, W_BB = W_BA + 1024 * 256 * 2, W_BC = W_BB + 1024 * 256 * 2,
                 W_BD = W_BC + 1024 * 512 * 2, W_OUT = W_BD + 1024 * 256 * 2, W_UP = W_OUT + 1024 * 1024 * 2, W_DN = W_UP + (size_t)5632 * 1024 * 2, W_L = W_DN + (size_t)1024 * 2816 * 2,
                 W_END = W_L + 1024 * 512 * 2;
constexpr size_t WS_END = WS_SR + (size_t)M * 1024 * 2;
static_assert(W_END == 37748736 && WS_SKK + (size_t)M * 256 * 2 <= WS_END && WS_END <= (size_t)1073741824, "workspace map");
constexpr size_t OFF_T = 0, OFF_MRG = (size_t)M * 1024 * 2;

struct Params { const float* in[29]; float* out; unsigned char* ws; int ph_lo, ph_hi; };

__device__ __forceinline__ int opq(int i) { asm volatile("" : "+s"(i)); return i; }
#define INP(i) (p.in[opq(i)])
__device__ __forceinline__ float bflo(unsigned w) { return __uint_as_float(w << 16); }
__device__ __forceinline__ float bfhi(unsigned w) { return __uint_as_float(w & 0xffff0000u); }
__device__ __forceinline__ unsigned f2bf(float f) { unsigned u = __float_as_uint(f); return (u + 0x7fffu + ((u >> 16) & 1u)) >> 16; }
__device__ __forceinline__ unsigned pk2(float lo, float hi) { return f2bf(lo) | (f2bf(hi) << 16); }
__device__ __forceinline__ f32x4 up4bf(const u32x2 w) { return (f32x4){bflo(w.x), bfhi(w.x), bflo(w.y), bfhi(w.y)}; }
__device__ __forceinline__ f32x4 ld4bf(const bf16* p) { const u32x2 w = *(const u32x2*)p; return (f32x4){bflo(w.x), bfhi(w.x), bflo(w.y), bfhi(w.y)}; }
__device__ __forceinline__ void st4bf(bf16* p, f32x4 v) { u32x2 w; w.x = pk2(v.x, v.y); w.y = pk2(v.z, v.w); *(u32x2*)p = w; }
__device__ __forceinline__ float sigm(float x) { return __builtin_amdgcn_rcpf(1.0f + __expf(-x)); }
__device__ __forceinline__ float shx(float v, int o, int lane) { return __int_as_float(__builtin_amdgcn_ds_bpermute((lane ^ o) << 2, __float_as_int(v))); }
__device__ __forceinline__ float wave_sum(float v, int lane) {
#pragma unroll
    for (int o = 1; o < 64; o <<= 1) v += shx(v, o, lane);
    return v;
}
template <int CTRL> __device__ __forceinline__ float dppf(float x) { return __int_as_float(__builtin_amdgcn_mov_dpp(__float_as_int(x), CTRL, 0xF, 0xF, true)); }
__device__ __forceinline__ float row16_sum(float x) {
    x += dppf<0xB1>(x);
    x += dppf<0x4E>(x);
    x += dppf<0x141>(x);
    x += dppf<0x140>(x);
    return x;
}
#define OPQ_TID(tid) asm volatile("" : "+v"(tid))
#define WAVE_IDS(tid) const int lane = tid & 63, wave = __builtin_amdgcn_readfirstlane(tid >> 6), gw = blockIdx.x * 8 + wave, ngw = gridDim.x * 8; (void)lane; (void)wave; (void)gw; (void)ngw
#define LDS_WAIT() asm volatile("s_waitcnt lgkmcnt(0)" ::: "memory")

template <int MODE>
__device__ __forceinline__ void norm_phase(const Params& p, const float* gamma, int tid) {
    OPQ_TID(tid); WAVE_IDS(tid);
    bf16* H = (bf16*)(p.ws + WS_H);
    bf16* Z = (bf16*)p.out;
    f32x4 gv[4];
#pragma unroll
    for (int j = 0; j < 4; ++j) gv[j] = ((const f32x4*)gamma)[lane + 64 * j];
    for (int m0 = gw; m0 < M; m0 += 4 * ngw) {
        f32x4 vv[4][4];
#pragma unroll
        for (int q = 0; q < 4; ++q) { const int m = m0 + q * ngw;
            if (m < M) { const int b = m / L, t = m - b * L;
                if (MODE == 1) { const float* src = (t < NMETA) ? INP(1) + (size_t)t * DM : INP(0) + ((size_t)b * SEQ + (t - NMETA)) * DM;
#pragma unroll
                    for (int j = 0; j < 4; ++j) vv[q][j] = ((const f32x4*)src)[lane + 64 * j];
                } else {
#pragma unroll
                    for (int j = 0; j < 4; ++j) vv[q][j] = ld4bf(H + (size_t)m * DM + 4 * lane + 256 * j);
                } } }
#pragma unroll
        for (int q = 0; q < 4; ++q) { const int m = m0 + q * ngw;
            if (m < M) { const int b = m / L, t = m - b * L;
                f32x4 v[4]; float ss = 0.f;
#pragma unroll
                for (int j = 0; j < 4; ++j) { v[j] = vv[q][j]; ss += (v[j].x * v[j].x + v[j].y * v[j].y) + (v[j].z * v[j].z + v[j].w * v[j].w); }
                ss = wave_sum(ss, lane);
                const float rstd = rsqrtf(ss * (1.0f / DM) + 1e-6f);
                if (MODE == 1) {
#pragma unroll
                    for (int j = 0; j < 4; ++j) st4bf(H + (size_t)m * DM + 4 * lane + 256 * j, v[j]);
                }
                if (MODE == 2) {
                    if (t >= NMETA) { f32x4* o4 = (f32x4*)(p.out + ((size_t)b * SEQ + (t - NMETA)) * DM);
#pragma unroll
                        for (int j = 0; j < 4; ++j) o4[lane + 64 * j] = v[j] * rstd * gv[j]; }
                } else {
#pragma unroll
                    for (int j = 0; j < 4; ++j) st4bf(Z + (size_t)m * DM + 4 * lane + 256 * j, v[j] * rstd * gv[j]);
                }
            } }
    }
}

__device__ __forceinline__ void tr_item(const float* W, int N, int k0, int n0, bf16* D, int ld, int kd0, int nsub, int upmode, LAS float* scr, int lane) {
    float wv[32];
#pragma unroll
    for (int i = 0; i < 32; ++i) wv[i] = __builtin_nontemporal_load(W + (size_t)(k0 + 2 * i + (lane >> 5)) * N + n0 + (lane & 31));
#pragma unroll
    for (int i = 0; i < 32; ++i) scr[(2 * i + (lane >> 5)) * 33 + (lane & 31)] = wv[i];
    LDS_WAIT();
    const int c = lane & 7;
#pragma unroll
    for (int j = 0; j < 4; ++j) { const int n = (lane >> 3) + 8 * j; const LAS float* s = scr + (8 * c) * 33 + n;
        u32x4 o; o.x = pk2(s[0 * 33], s[1 * 33]); o.y = pk2(s[2 * 33], s[3 * 33]); o.z = pk2(s[4 * 33], s[5 * 33]); o.w = pk2(s[6 * 33], s[7 * 33]);
        const int ng = n0 + n; int dr;
        if (upmode == 1) { const int up = ng >= DFF ? 1 : 0, jj = ng - up * DFF; dr = (jj >> 4) * 32 + up * 16 + (jj & 15); }
        else if (upmode == 2) { const int bi = ng >> 10, jj = ng & 1023; dr = 256 * (jj >> 6) + 128 * (bi >> 1) + 32 * ((jj >> 4) & 3) + 16 * (bi & 1) + (jj & 15); }
        else dr = ng - nsub;
        *(u32x4*)(D + (size_t)dr * ld + kd0 + 8 * c) = o; }
    LDS_WAIT();
}
__device__ __forceinline__ void convert_phase(const Params& p, int layer, LAS unsigned char* lds, int tid) {
    OPQ_TID(tid); WAVE_IDS(tid);
    LAS float* scr = (LAS float*)(lds + wave * 16384);
    unsigned char* wb = p.ws + WS_W;
    constexpr int I_IN = 16 * 224, I_BR = 20 * 32, I_OUT = 16 * 32, I_UP = 16 * 176, I_DN = 44 * 32, NIT = I_IN + I_BR + I_OUT + I_UP + I_DN;
    const float* w_in = INP(5) + (size_t)layer * 1024 * 7168;
    const float* w_br = INP(6) + (size_t)layer * 1280 * 1024;
    const float* w_out = INP(7) + (size_t)layer * 1024 * 1024;
    const float* w_up = INP(27) + (size_t)layer * 1024 * 5632;
    const float* w_dn = INP(28) + (size_t)layer * 2816 * 1024;
    for (int it = gw; it < NIT; it += ngw) {
        int r = it;
        if (r < I_IN) { const int kb = r / 224, nb = r % 224, n0 = 32 * nb;
            if (n0 < 4096) tr_item(w_in, 7168, 64 * kb, n0, (bf16*)(wb + W_G), 1024, 64 * kb, 0, 2, scr, lane);
            else tr_item(w_in, 7168, 64 * kb, n0, (bf16*)(wb + W_IN), 1024, 64 * kb, 4096, 0, scr, lane);
            continue; }
        r -= I_IN;
        if (r < I_BR) { const int kb = r / 32, nb = r % 32, k0 = 64 * kb;
            if (kb < 4) tr_item(w_br, 1024, k0, 32 * nb, (bf16*)(wb + W_BA), 256, k0, 0, 0, scr, lane);
            else if (kb < 8) tr_item(w_br, 1024, k0, 32 * nb, (bf16*)(wb + W_BB), 256, k0 - 256, 0, 0, scr, lane);
            else if (kb < 16) tr_item(w_br, 1024, k0, 32 * nb, (bf16*)(wb + W_BC), 512, k0 - 512, 0, 0, scr, lane);
            else tr_item(w_br, 1024, k0, 32 * nb, (bf16*)(wb + W_BD), 256, k0 - 1024, 0, 0, scr, lane);
            continue; }
        r -= I_BR;
        if (r < I_OUT) { const int kb = r / 32, nb = r % 32; tr_item(w_out, 1024, 64 * kb, 32 * nb, (bf16*)(wb + W_OUT), 1024, 64 * kb, 0, 0, scr, lane); continue; }
        r -= I_OUT;
        if (r < I_UP) { const int kb = r / 176, nb = r % 176; tr_item(w_up, 5632, 64 * kb, 32 * nb, (bf16*)(wb + W_UP), 1024, 64 * kb, 0, 1, scr, lane); continue; }
        r -= I_UP;
        { const int kb = r / 32, nb = r % 32; tr_item(w_dn, 1024, 64 * kb, 32 * nb, (bf16*)(wb + W_DN), 2816, 64 * kb, 0, 0, scr, lane); }
    }
    {
        bf16* WL = (bf16*)(wb + W_L);
        const float* wup = INP(9) + (size_t)layer * 64 * 256;
        const float* aup = INP(11) + (size_t)layer * 64 * 256;
        const float* gup = INP(13) + (size_t)layer * 128 * 256;
        const float* vdn = INP(19) + (size_t)(layer > 0 ? layer - 1 : 0) * 256 * 32;
        const float* vup = INP(20) + (size_t)(layer > 0 ? layer - 1 : 0) * 32 * 256;
        const int nthr = gridDim.x * 512;
        for (int idx = blockIdx.x * 512 + tid; idx < 1024 * 256; idx += nthr) {
            const int n = idx >> 8, kx = idx & 255; float v = 0.f;
            if (n < 256) { if (kx < 64) v = wup[kx * 256 + n]; }
            else if (n < 512) { if (kx >= 64 && kx < 128) v = aup[(kx - 64) * 256 + (n - 256)]; }
            else if (n < 768) { if (kx >= 128) v = gup[(kx - 128) * 256 + (n - 512)]; }
            else { if (layer > 0) { float s = 0.f;
#pragma unroll 8
                    for (int j = 0; j < 32; ++j) s += vdn[kx * 32 + j] * vup[j * 256 + (n - 768)];
                    v = s; } }
            WL[idx] = (bf16)f2bf(v);
        }
    }
    if (layer == 0 && blockIdx.x == 0 && tid < 256) {
        const float* d = INP(25); float* LBT = (float*)(p.ws + WS_CTL + 4096);
        const float d0 = d[tid], d1 = d[256 + tid], d2 = d[512 + tid], d3 = d[768 + tid];
        const float mx = fmaxf(fmaxf(d0, d1), fmaxf(d2, d3));
        const float e0 = expf(d0 - mx), e1 = expf(d1 - mx), e2 = expf(d2 - mx), e3 = expf(d3 - mx);
        const float inv = 1.0f / (e0 + e1 + e2 + e3);
        LBT[tid] = 0.f; LBT[256 + tid] = e1 * inv; LBT[512 + tid] = (e1 + e2) * inv; LBT[768 + tid] = (e1 + e2 + e3) * inv;
    }
}

__device__ __forceinline__ void prep1_phase(const Params& p, int layer, int tid) {
    OPQ_TID(tid); WAVE_IDS(tid);
    const bf16* PROJ = (const bf16*)(p.ws + WS_PROJ);
    bf16* XA = (bf16*)(p.ws + WS_Y); bf16* XVv = XA + (size_t)M * 256; bf16* SR = (bf16*)(p.ws + WS_SR); bf16* SK = (bf16*)(p.ws + WS_SK);
    const float* mu = INP(8) + (size_t)layer * 1024;
    f32x4 mu4[4];
#pragma unroll
    for (int s = 0; s < 4; ++s) mu4[s] = *(const f32x4*)(mu + s * 256 + 4 * lane);
    const int c4 = 4 * lane;
    for (int m0 = gw; m0 < M; m0 += 4 * ngw) {
        u32x2 ra[4][4], rb[4][4];
#pragma unroll
        for (int q = 0; q < 4; ++q) { const int m = m0 + q * ngw;
            if (m < M) { const int t = m % L; const bf16* cur = PROJ + (size_t)m * PC;
#pragma unroll
                for (int s = 0; s < 4; ++s) { ra[q][s] = *(const u32x2*)(cur + s * 256 + c4); rb[q][s] = (u32x2){0u, 0u}; if (t > 0) rb[q][s] = *(const u32x2*)(cur - PC + s * 256 + c4); } } }
#pragma unroll
        for (int q = 0; q < 4; ++q) { const int m = m0 + q * ngw;
            if (m < M) {
                f32x4 u[4];
#pragma unroll
                for (int s = 0; s < 4; ++s) { const f32x4 a = up4bf(ra[q][s]), b = up4bf(rb[q][s]); u[s] = a + (b - a) * mu4[s]; }
                st4bf(SR + (size_t)m * 256 + c4, u[0]);
                st4bf(SK + (size_t)m * 256 + c4, u[1]);
                st4bf(XVv + (size_t)m * 256 + c4, u[2]);
                f32x4 x = u[3];
                if (c4 < 64) {
#pragma unroll
                    for (int e = 0; e < 4; ++e) { const float tt = __expf(2.0f * x[e]); x[e] = 1.0f - 2.0f * __builtin_amdgcn_rcpf(tt + 1.0f); }
                } else if (c4 >= 128) {
#pragma unroll
                    for (int e = 0; e < 4; ++e) x[e] = sigm(x[e]);
                }
                st4bf(XA + (size_t)m * 256 + c4, x);
            } }
    }
}

__device__ __forceinline__ void prep2_phase(const Params& p, int layer, int tid) {
    OPQ_TID(tid); WAVE_IDS(tid);
    bf16* PROJ = (bf16*)(p.ws + WS_PROJ);
    const bf16* XVv = (const bf16*)(p.ws + WS_Y) + (size_t)M * 256; bf16* SK = (bf16*)(p.ws + WS_SK); bf16* SKK = (bf16*)(p.ws + WS_SKK); bf16* VF = (bf16*)(p.ws + WS_VF);
    const int c4 = 4 * lane;
    const f32x4 w0 = *(const f32x4*)(INP(10) + layer * 256 + c4), a0 = *(const f32x4*)(INP(12) + layer * 256 + c4);
    const f32x4 kkw = *(const f32x4*)(INP(14) + layer * 256 + c4), kaw = *(const f32x4*)(INP(15) + layer * 256 + c4);
    f32x4 vr0 = (f32x4){0.f, 0.f, 0.f, 0.f};
    if (layer > 0) vr0 = *(const f32x4*)(INP(21) + (layer - 1) * 256 + c4);
    for (int m0 = gw; m0 < M; m0 += 4 * ngw) {
        u32x2 rw[4][6];
#pragma unroll
        for (int q = 0; q < 4; ++q) { const int m = m0 + q * ngw;
            if (m < M) { const bf16* pr = PROJ + (size_t)m * PC;
                rw[q][0] = *(const u32x2*)(pr + c4); rw[q][1] = *(const u32x2*)(pr + 256 + c4); rw[q][2] = *(const u32x2*)(pr + 768 + c4);
                rw[q][3] = *(const u32x2*)(XVv + (size_t)m * 256 + c4); rw[q][4] = *(const u32x2*)(SK + (size_t)m * 256 + c4);
                rw[q][5] = (u32x2){0u, 0u}; if (layer > 0) rw[q][5] = *(const u32x2*)(VF + (size_t)m * 256 + c4); } }
#pragma unroll
        for (int q = 0; q < 4; ++q) { const int m = m0 + q * ngw;
            if (m < M) {
                bf16* pr = PROJ + (size_t)m * PC;
                const f32x4 wl = up4bf(rw[q][0]), al = up4bf(rw[q][1]), vr = up4bf(rw[q][2]), v = up4bf(rw[q][3]), k = up4bf(rw[q][4]);
                f32x4 lw, a, kkv, kn, vn;
                float ss = 0.f;
#pragma unroll
                for (int e = 0; e < 4; ++e) {
                    const float x = w0[e] + wl[e];
                    const float sp = fmaxf(-x, 0.f) + __logf(1.0f + __expf(-fabsf(x)));
                    lw[e] = -__expf(-sp - 0.5f);
                    a[e] = sigm(a0[e] + al[e]);
                    kkv[e] = k[e] * kkw[e]; ss += kkv[e] * kkv[e];
                    kn[e] = k[e] * (1.0f + (a[e] - 1.0f) * kaw[e]);
                }
                ss = row16_sum(ss);
                const float inv = 1.0f / fmaxf(sqrtf(ss), 1e-12f);
                if (layer > 0) { const f32x4 vf = up4bf(rw[q][5]);
#pragma unroll
                    for (int e = 0; e < 4; ++e) vn[e] = v[e] + (vf[e] - v[e]) * sigm(vr0[e] + vr[e]);
                } else { vn = v; st4bf(VF + (size_t)m * 256 + c4, v); }
                f32x4 kkn = kkv * inv;
                st4bf(pr + c4, lw);
                st4bf(pr + 256 + c4, kkn * a);
                st4bf(pr + 768 + c4, vn);
                st4bf(SK + (size_t)m * 256 + c4, kn);
                st4bf(SKK + (size_t)m * 256 + c4, kkn);
            } }
    }
}

__device__ __forceinline__ void scan_phase(const Params& p, int layer, LAS unsigned char* lds, int tid) {
    OPQ_TID(tid);
    typedef float f32x2 __attribute__((ext_vector_type(2)));
    const bf16* PROJ = (const bf16*)(p.ws + WS_PROJ);
    const bf16* SR = (const bf16*)(p.ws + WS_SR); const bf16* SK = (const bf16*)(p.ws + WS_SK); const bf16* SKK = (const bf16*)(p.ws + WS_SKK);
    bf16* YA = (bf16*)(p.ws + WS_Y); bf16* YD = (bf16*)(p.ws + WS_Y + (size_t)M * 2048);
    const float* LBT = (const float*)(p.ws + WS_CTL + 4096) + layer * 256;
    constexpr int O_RV = 5120, O_HW = 5376, O_HV = 7424, IN_F = 7680, OUT_F = 2048, O_HO = 1024;
    LAS float* INB = (LAS float*)lds;
    LAS float* OUTB = INB + 2 * IN_F;
    const int cw = tid >> 6, lane = tid & 63, kq = lane & 15, lt = tid & 127;
    const bool cR = cw < 4, cH = (cw == 4) || (cw == 5);
    const int rrow = cw * 4 + (lane >> 4);
    const int r0 = (cw & 1) * 8 + (lane >> 4) * 2;
    constexpr int NCH = L / 16;
    for (int item = blockIdx.x; item < 256; item += gridDim.x) {
        const int b = item >> 4, h = (item >> 2) & 3, rq = item & 3;
        const size_t mb = (size_t)b * L;
        const bf16* sp[8]; int sld[8], sk[8], sd[8];
        float lbv[8];
#pragma unroll
        for (int e = 0; e < 8; ++e) lbv[e] = 0.f;
#pragma unroll
        for (int i = 0; i < 8; ++i) {
            const int idx = lt + 128 * i; sp[i] = PROJ; sld[i] = 0; sk[i] = -1; sd[i] = 0;
            if (idx < 640) { const int vec = idx >> 7, rem = idx & 127, st = rem >> 3, ch = rem & 7; const int co = h * 64 + ch * 8;
                if (vec == 0) { sp[i] = SKK + (mb + st) * 256 + co; sld[i] = 256; } else if (vec == 1) { sp[i] = PROJ + (mb + st) * PC + co; sld[i] = PC; }
                else if (vec == 2) { sp[i] = PROJ + (mb + st) * PC + 256 + co; sld[i] = PC; } else if (vec == 3) { sp[i] = SK + (mb + st) * 256 + co; sld[i] = 256; }
                else { sp[i] = SR + (mb + st) * 256 + co; sld[i] = 256; }
                sk[i] = (vec == 1) ? 1 : 0; sd[i] = ((st * 16 + 2 * ch) * 5 + vec) * 4; }
            else if (idx < 672) { const int vi = idx - 640, st = vi >> 1, hf = vi & 1; sp[i] = PROJ + (mb + st) * PC + 768 + h * 64 + rq * 16 + hf * 8; sld[i] = PC; sk[i] = 2; sd[i] = O_RV + st * 16 + hf * 8; }
            else if (idx < 928) { const int j = idx - 672, st = (j & 127) >> 3, ch = j & 7;
                if (j < 128) { sp[i] = PROJ + (mb + st) * PC + 2048 + h * 64 + ch * 8; sk[i] = 3; sd[i] = O_HW + ((st * 16 + 2 * ch) * 2 + 1) * 4; }
                else { sp[i] = PROJ + (mb + st) * PC + 2304 + h * 64 + ch * 8; sk[i] = 4; sd[i] = O_HW + ((st * 16 + 2 * ch) * 2) * 4;
#pragma unroll
                    for (int e = 0; e < 8; ++e) lbv[e] = LBT[h * 64 + ch * 8 + e]; }
                sld[i] = PC; }
            else if (idx < 960) { const int vi = idx - 928, st = vi >> 1, hf = vi & 1; sp[i] = PROJ + (mb + st) * PC + 2560 + h * 64 + rq * 16 + hf * 8; sld[i] = PC; sk[i] = 2; sd[i] = O_HV + st * 16 + hf * 8; }
        }
        u32x4 preA[8], preB[8];
#pragma unroll
        for (int i = 0; i < 8; ++i) { preA[i] = (u32x4){0, 0, 0, 0}; preB[i] = (u32x4){0, 0, 0, 0}; }
#define SC_LOAD(P, chunk) do { _Pragma("unroll") for (int i = 0; i < 8; ++i) if (sk[i] >= 0) P[i] = *(const u32x4*)(sp[i] + (size_t)(chunk) * 16 * sld[i]); } while (0)
#define SC_ST4(off, a, b, c, d) *(LAS f32x4*)(dstb + (off)) = (f32x4){a, b, c, d}
#define SC_STAGE(P, dstb) do { _Pragma("unroll") for (int i = 0; i < 8; ++i) if (sk[i] >= 0) { \
            float f[8]; f[0] = bflo(P[i].x); f[1] = bfhi(P[i].x); f[2] = bflo(P[i].y); f[3] = bfhi(P[i].y); f[4] = bflo(P[i].z); f[5] = bfhi(P[i].z); f[6] = bflo(P[i].w); f[7] = bfhi(P[i].w); \
            const int o_ = sd[i]; \
            if (sk[i] == 0) { SC_ST4(o_, f[0], f[1], f[2], f[3]); SC_ST4(o_ + 20, f[4], f[5], f[6], f[7]); } \
            else if (sk[i] == 1) { _Pragma("unroll") for (int e = 0; e < 8; ++e) f[e] = __expf(f[e]); SC_ST4(o_, f[0], f[1], f[2], f[3]); SC_ST4(o_ + 20, f[4], f[5], f[6], f[7]); } \
            else if (sk[i] == 2) { SC_ST4(o_, f[0], f[1], f[2], f[3]); SC_ST4(o_ + 4, f[4], f[5], f[6], f[7]); } \
            else if (sk[i] == 3) { _Pragma("unroll") for (int e = 0; e < 8; ++e) f[e] = f[e] * sigm(f[e]); SC_ST4(o_, f[0], f[1], f[2], f[3]); SC_ST4(o_ + 8, f[4], f[5], f[6], f[7]); } \
            else { _Pragma("unroll") for (int e = 0; e < 8; ++e) f[e] = lbv[e] + (1.0f - lbv[e]) * sigm(f[e]); SC_ST4(o_, f[0], f[1], f[2], f[3]); SC_ST4(o_ + 8, f[4], f[5], f[6], f[7]); } } } while (0)
        if (!cR && !cH) { SC_LOAD(preA, 0); SC_LOAD(preB, 1); { LAS float* dstb = INB; SC_STAGE(preA, dstb); } SC_LOAD(preA, 2); }
        f32x2 S01 = (f32x2){0.f, 0.f}, S23 = S01;
        f32x2 H0 = (f32x2){0.f, 0.f}, H1 = H0, H2 = H0, H3 = H0;
        __syncthreads();
        for (int c = 0; c < NCH; ++c) {
            const int bi = c & 1;
            LAS float* inb = INB + bi * IN_F; LAS float* outb = OUTB + bi * OUT_F;
            if (cR) {
                const LAS float* RW = inb; const LAS float* RV = inb + O_RV; LAS float* RO = outb;
                const LAS f32x4* q = (const LAS f32x4*)(RW + kq * 20);
                f32x4 kk = q[0], w = q[1], bb = q[2], k = q[3], r = q[4]; float v = RV[rrow];
#pragma unroll
                for (int s = 0; s < 16; ++s) {
                    f32x4 nkk = kk, nw = w, nbb = bb, nk = k, nr = r; float nv = v;
                    if (s < 15) { const LAS f32x4* qn = (const LAS f32x4*)(RW + ((s + 1) * 16 + kq) * 20);
                        nkk = qn[0]; nw = qn[1]; nbb = qn[2]; nk = qn[3]; nr = qn[4]; nv = RV[(s + 1) * 16 + rrow]; }
                    const f32x2 p2 = S01 * kk.xy + S23 * kk.zw;
                    float pd = p2.x + p2.y;
                    const f32x2 a01 = S01 * w.xy + k.xy * v, a23 = S23 * w.zw + k.zw * v;
                    pd = row16_sum(pd);
                    S01 = a01 - bb.xy * pd; S23 = a23 - bb.zw * pd;
                    const f32x2 o2 = S01 * r.xy + S23 * r.zw;
                    float o = o2.x + o2.y;
                    o += dppf<0xB1>(o); o += dppf<0x4E>(o);
                    if ((kq & 3) == 0) RO[(s * 4 + (kq >> 2)) * 16 + rrow] = o;
                    kk = nkk; w = nw; bb = nbb; k = nk; r = nr; v = nv;
                }
            } else if (cH) {
                const LAS float* HW = inb + O_HW; const LAS float* HV = inb + O_HV; LAS float* HO = outb + O_HO;
                const LAS f32x4* q = (const LAS f32x4*)(HW + kq * 8);
                f32x4 f = q[0], qq = q[1]; f32x2 v2 = *(const LAS f32x2*)(HV + r0);
#pragma unroll
                for (int s = 0; s < 16; ++s) {
                    f32x4 nf = f, nqq = qq; f32x2 nv = v2;
                    if (s < 15) { const LAS f32x4* qn = (const LAS f32x4*)(HW + ((s + 1) * 16 + kq) * 8); nf = qn[0]; nqq = qn[1]; nv = *(const LAS f32x2*)(HV + (s + 1) * 16 + r0); }
                    H0 = v2 + (H0 - v2) * f.x; H1 = v2 + (H1 - v2) * f.y; H2 = v2 + (H2 - v2) * f.z; H3 = v2 + (H3 - v2) * f.w;
                    f32x2 o = (H0 * qq.x + H1 * qq.y) + (H2 * qq.z + H3 * qq.w);
                    o.x += dppf<0xB1>(o.x); o.y += dppf<0xB1>(o.y); o.x += dppf<0x4E>(o.x); o.y += dppf<0x4E>(o.y);
                    if ((kq & 3) == 0) *(LAS f32x2*)(HO + (s * 4 + (kq >> 2)) * 16 + r0) = o;
                    f = nf; qq = nqq; v2 = nv;
                }
            } else {
                if (c > 0) {
#pragma unroll
                    for (int i = 0; i < 2; ++i) { const int oi = lt + 128 * i;
                        const LAS float* po = OUTB + (bi ^ 1) * OUT_F + (oi >> 4) * 64 + (oi & 15);
                        const size_t mo = (mb + (size_t)(c - 1) * 16 + (oi >> 4)) * 256 + h * 64 + rq * 16 + (oi & 15);
                        YA[mo] = (bf16)f2bf((po[0] + po[16]) + (po[32] + po[48]));
                        YD[mo] = (bf16)f2bf((po[O_HO] + po[O_HO + 16]) + (po[O_HO + 32] + po[O_HO + 48])); }
                }
                if (c + 1 < NCH) {
                    if (bi == 0) { LAS float* dstb = INB + IN_F; SC_STAGE(preB, dstb); if (c + 3 < NCH) SC_LOAD(preB, c + 3); }
                    else { LAS float* dstb = INB; SC_STAGE(preA, dstb); if (c + 3 < NCH) SC_LOAD(preA, c + 3); }
                }
            }
            __syncthreads();
        }
        if (!cR && !cH) {
#pragma unroll
            for (int i = 0; i < 2; ++i) { const int oi = lt + 128 * i;
                const LAS float* po = OUTB + ((NCH - 1) & 1) * OUT_F + (oi >> 4) * 64 + (oi & 15);
                const size_t mo = (mb + (size_t)(NCH - 1) * 16 + (oi >> 4)) * 256 + h * 64 + rq * 16 + (oi & 15);
                YA[mo] = (bf16)f2bf((po[0] + po[16]) + (po[32] + po[48]));
                YD[mo] = (bf16)f2bf((po[O_HO] + po[O_HO + 16]) + (po[O_HO + 32] + po[O_HO + 48])); }
        }
        __syncthreads();
#undef SC_LOAD
#undef SC_ST4
#undef SC_STAGE
    }
}

__device__ __forceinline__ void post_phase(const Params& p, int layer, int tid) {
    OPQ_TID(tid); WAVE_IDS(tid);
    const bf16* PROJ = (const bf16*)(p.ws + WS_PROJ);
    const bf16* SR = (const bf16*)(p.ws + WS_SR); const bf16* SK = (const bf16*)(p.ws + WS_SK);
    bf16* YA = (bf16*)(p.ws + WS_Y); bf16* YD = (bf16*)(p.ws + WS_Y + (size_t)M * 2048);
    const int c4 = 4 * lane;
    const f32x4 lnw = *(const f32x4*)(INP(17) + layer * 256 + c4), lnb = *(const f32x4*)(INP(18) + layer * 256 + c4), rk = *(const f32x4*)(INP(16) + layer * 256 + c4);
    const f32x4 dn = *(const f32x4*)(INP(26) + layer * 256 + c4);
    for (int m0 = gw; m0 < M; m0 += 4 * ngw) {
        u32x2 rw[4][7];
#pragma unroll
        for (int q = 0; q < 4; ++q) { const int m = m0 + q * ngw;
            if (m < M) { const bf16* pr = PROJ + (size_t)m * PC;
                rw[q][0] = *(const u32x2*)(YA + (size_t)m * 256 + c4); rw[q][1] = *(const u32x2*)(SR + (size_t)m * 256 + c4); rw[q][2] = *(const u32x2*)(SK + (size_t)m * 256 + c4);
                rw[q][3] = *(const u32x2*)(pr + 768 + c4); rw[q][4] = *(const u32x2*)(pr + 512 + c4);
                rw[q][5] = *(const u32x2*)(YD + (size_t)m * 256 + c4); rw[q][6] = *(const u32x2*)(pr + 2816 + c4); } }
#pragma unroll
        for (int q = 0; q < 4; ++q) { const int m = m0 + q * ngw;
            if (m < M) {
                {
                    const f32x4 o = up4bf(rw[q][0]);
                    const float mean = row16_sum((o.x + o.y) + (o.z + o.w)) * (1.0f / 64.0f);
                    const f32x4 d = o - mean;
                    const float var = row16_sum((d.x * d.x + d.y * d.y) + (d.z * d.z + d.w * d.w)) * (1.0f / 64.0f);
                    const float rs = rsqrtf(var + 64e-5f);
                    const f32x4 r = up4bf(rw[q][1]), k = up4bf(rw[q][2]), v = up4bf(rw[q][3]), g = up4bf(rw[q][4]);
                    const f32x4 rkk = r * k * rk;
                    const float dot = row16_sum((rkk.x + rkk.y) + (rkk.z + rkk.w));
                    const f32x4 y = (d * rs * lnw + lnb + v * dot) * g;
                    st4bf(YA + (size_t)m * 256 + c4, y);
                }
                {
                    const f32x4 o = up4bf(rw[q][5]);
                    const float ms = row16_sum((o.x * o.x + o.y * o.y) + (o.z * o.z + o.w * o.w)) * (1.0f / 64.0f);
                    const float rs = rsqrtf(ms + 1e-6f);
                    const f32x4 g = up4bf(rw[q][6]);
                    f32x4 y;
#pragma unroll
                    for (int e = 0; e < 4; ++e) y[e] = o[e] * rs * dn[e] * (g[e] * sigm(g[e]));
                    st4bf(YD + (size_t)m * 256 + c4, y);
                }
            } }
    }
}

__device__ __forceinline__ void pool_phase(const Params& p, int layer, LAS unsigned char* lds, int tid) {
    OPQ_TID(tid);
    const bf16* PROJ = (const bf16*)(p.ws + WS_PROJ);
    bf16* YB = (bf16*)(p.ws + WS_Y + (size_t)M * 512);
    LAS float* U = (LAS float*)lds;
    LAS bf16* PB = (LAS bf16*)(lds + 48128);
    LAS bf16* MT = (LAS bf16*)(lds + 48128 + 16896);
    const float* mix = INP(22) + (size_t)layer * 4 * 64 * 64;
    const float* scale = INP(23) + layer * 256;
    const int wave = tid >> 6, lane = tid & 63, l15 = lane & 15, quad = lane >> 4;
    __syncthreads();
    for (int i = 0; i < 32; ++i) { const int idx = tid + 512 * i, g = idx >> 12, c = (idx >> 6) & 63, d = idx & 63; MT[(g * 64 + d) * 72 + c] = (bf16)f2bf(mix[idx] * scale[g * 64 + d]); }
    for (int tile = blockIdx.x; tile < M / 32; tile += gridDim.x) {
        const int m0 = tile * 32;
        __syncthreads();
#pragma unroll
        for (int i = 0; i < 3; ++i) { const int idx = tid + i * 512;
            if (idx < 47 * 32) { const int r = idx >> 5, ch = idx & 31, mm = m0 - 15 + r;
                u32x4 w = (u32x4){0, 0, 0, 0};
                if (mm >= 0) w = *(const u32x4*)(PROJ + (size_t)mm * PC + 1024 + ch * 8);
                LAS float* d = U + r * 256 + ch * 8;
                *(LAS f32x4*)d = (f32x4){bflo(w.x), bfhi(w.x), bflo(w.y), bfhi(w.y)}; *(LAS f32x4*)(d + 4) = (f32x4){bflo(w.z), bfhi(w.z), bflo(w.w), bfhi(w.w)}; } }
        __syncthreads();
        {
            const int c = tid & 255, rb = (tid >> 8) * 16, g = c >> 6, w = 2 << g; const float invw = 1.0f / (float)w;
            float sum = 0.f;
            for (int j = 0; j < w; ++j) sum += U[(15 + rb - j) * 256 + c];
            int t = (m0 + rb) % L;
            for (int i = 0; i < 16; ++i) {
                const int r = rb + i; const float cur = U[(15 + r) * 256 + c];
                if (i > 0) sum += cur - U[(15 + r - w) * 256 + c];
                float pv;
                if (t + 1 >= w) pv = sum * invw - cur;
                else { float s2 = 0.f; for (int j = 0; j <= t; ++j) s2 += U[(15 + r - j) * 256 + c]; pv = s2 / (float)(t + 1) - cur; }
                PB[r * 264 + c] = (bf16)f2bf(pv);
                t = (t + 1 == L) ? 0 : t + 1;
            }
        }
        __syncthreads();
        {
            const int g = wave >> 1, mt = wave & 1;
            bf16x8 a[2];
#pragma unroll
            for (int ks = 0; ks < 2; ++ks) a[ks] = *(const LAS bf16x8*)(PB + (mt * 16 + l15) * 264 + g * 64 + ks * 32 + quad * 8);
#pragma unroll
            for (int nt = 0; nt < 4; ++nt) {
                f32x4 acc = (f32x4){0.f, 0.f, 0.f, 0.f};
#pragma unroll
                for (int ks = 0; ks < 2; ++ks) { const bf16x8 bfr = *(const LAS bf16x8*)(MT + (g * 64 + nt * 16 + l15) * 72 + ks * 32 + quad * 8);
                    acc = __builtin_amdgcn_mfma_f32_16x16x32_bf16(a[ks], bfr, acc, 0, 0, 0); }
#pragma unroll
                for (int j = 0; j < 4; ++j) YB[(size_t)(m0 + mt * 16 + quad * 4 + j) * 256 + g * 64 + nt * 16 + l15] = (bf16)f2bf(acc[j]);
            }
        }
    }
}

template <bool EARLY>
__device__ __forceinline__ void attn_ct(const LAS bf16* Kb, const LAS bf16* Vb, const bf16x8 (&qf)[2], float fd, int rl, int l15, int smin, float slope2, float sink2, int lane, f32x4 (&oacc)[4], float& inv) {
    constexpr float LOG2E = 1.4426950408889634f;
    f32x4 sacc[9];
#pragma unroll
    for (int kk = 0; kk < 9; ++kk) sacc[kk] = (f32x4){0.f, 0.f, 0.f, 0.f};
#pragma unroll
    for (int kk = 0; kk < 9; ++kk)
#pragma unroll
        for (int ks = 0; ks < 2; ++ks) { const bf16x8 kf = *(const LAS bf16x8*)(Kb + kk * 16 * 72 + ks * 32);
            sacc[kk] = __builtin_amdgcn_mfma_f32_16x16x32_bf16(kf, qf[ks], sacc[kk], 0, 0, 0); if (ks == 1 && (kk & 1)) __builtin_amdgcn_sched_barrier(0); }
    float mx = -1e30f;
#pragma unroll
    for (int kk = 0; kk < 9; ++kk)
#pragma unroll
        for (int j = 0; j < 4; ++j) { const int rc = kk * 16 + j;
            float lg = sacc[kk][j] * (0.125f * LOG2E) - slope2 * (fd - (float)rc);
            if (kk == 0 || kk == 8 || EARLY) { bool ok = true;
                if (kk == 0) ok = (rc + rl) > l15;
                if (kk == 8) ok = (rc + rl) <= 128 + l15;
                if (EARLY) ok = ok && ((rc + rl) >= smin);
                lg = ok ? lg : -1e30f; }
            sacc[kk][j] = lg; mx = fmaxf(mx, lg); }
    mx = fmaxf(mx, shx(mx, 16, lane)); mx = fmaxf(mx, shx(mx, 32, lane)); mx = fmaxf(mx, sink2);
    float sum = 0.f;
#pragma unroll
    for (int kk = 0; kk < 9; ++kk)
#pragma unroll
        for (int j = 0; j < 4; ++j) { const float pe = __builtin_amdgcn_exp2f(sacc[kk][j] - mx); sacc[kk][j] = pe; sum += pe; }
    sum += shx(sum, 16, lane); sum += shx(sum, 32, lane); sum += __builtin_amdgcn_exp2f(sink2 - mx);
    inv = 1.0f / sum;
#pragma unroll
    for (int dt = 0; dt < 4; ++dt) oacc[dt] = (f32x4){0.f, 0.f, 0.f, 0.f};
#pragma unroll
    for (int kb = 0; kb < 5; ++kb) {
        u32x4 pw; pw.x = pk2(sacc[2 * kb][0], sacc[2 * kb][1]); pw.y = pk2(sacc[2 * kb][2], sacc[2 * kb][3]);
        if (2 * kb + 1 < 9) { pw.z = pk2(sacc[2 * kb + 1][0], sacc[2 * kb + 1][1]); pw.w = pk2(sacc[2 * kb + 1][2], sacc[2 * kb + 1][3]); } else { pw.z = 0u; pw.w = 0u; }
        const bf16x8 pf = __builtin_bit_cast(bf16x8, pw);
#pragma unroll
        for (int dt = 0; dt < 4; ++dt) { const LAS bf16* vp = Vb + dt * 16 * 200 + kb * 32;
            const u32x2 lo = *(const LAS u32x2*)vp; u32x2 hi = (u32x2){0u, 0u}; if (2 * kb + 1 < 9) hi = *(const LAS u32x2*)(vp + 16);
            u32x4 w; w.x = lo.x; w.y = lo.y; w.z = hi.x; w.w = hi.y; const bf16x8 vf = __builtin_bit_cast(bf16x8, w);
            oacc[dt] = __builtin_amdgcn_mfma_f32_16x16x32_bf16(vf, pf, oacc[dt], 0, 0, 0); }
        __builtin_amdgcn_sched_barrier(0);
    }
}
__device__ __forceinline__ void attn_phase(const Params& p, int layer, LAS unsigned char* lds, int tid) {
    OPQ_TID(tid);
    const bf16* PROJ = (const bf16*)(p.ws + WS_PROJ);
    bf16* YC = (bf16*)(p.ws + WS_Y + (size_t)M * 1024);
    LAS bf16* Ks = (LAS bf16*)lds;
    LAS bf16* Vt = (LAS bf16*)(lds + 27648);
    const int wave = tid >> 6, lane = tid & 63, l15 = lane & 15, quad = lane >> 4;
    const int g4 = wave >> 1, qh = wave & 1;
    constexpr int NQT = (L + 63) / 64;
    constexpr float LOG2E = 1.4426950408889634f;
    for (int item = blockIdx.x; item < BATCH * 2 * NQT; item += gridDim.x) {
        const int qt = item % NQT, bk = item / NQT, kvh = bk & 1, b = bk >> 1;
        const int t0 = qt * 64; const size_t mb = (size_t)b * L;
        __syncthreads();
#pragma unroll
        for (int i = 0; i < 3; ++i) { const int idx = tid + i * 512, row = idx >> 3, ch = idx & 7;
            int s = t0 - 128 + row; s = s < 0 ? 0 : (s > L - 1 ? L - 1 : s);
            const bf16* src = PROJ + (mb + s) * PC + 1792 + kvh * 64 + ch * 8;
            const u32x4 kv = *(const u32x4*)src; *(LAS u32x4*)(Ks + row * 72 + ch * 8) = kv;
            const u32x4 vv = *(const u32x4*)(src + 128);
            LAS bf16* vd = Vt + (ch * 8) * 200 + row;
            vd[0] = (bf16)(vv.x & 0xffffu); vd[200] = (bf16)(vv.x >> 16); vd[400] = (bf16)(vv.y & 0xffffu); vd[600] = (bf16)(vv.y >> 16);
            vd[800] = (bf16)(vv.z & 0xffffu); vd[1000] = (bf16)(vv.z >> 16); vd[1200] = (bf16)(vv.w & 0xffffu); vd[1400] = (bf16)(vv.w >> 16); }
        __syncthreads();
        const int hq = kvh * 4 + g4;
        const float slope2 = exp2f(-(float)(hq + 1)) * LOG2E, sink2 = INP(24)[layer * 8 + hq] * LOG2E;
#pragma unroll 1
        for (int ct = 0; ct < 2; ++ct) {
            const int kt0 = qh * 2 + ct;
            int tq = t0 + kt0 * 16 + l15; const int t = tq; tq = tq > L - 1 ? L - 1 : tq;
            bf16x8 qf[2];
#pragma unroll
            for (int ks = 0; ks < 2; ++ks) qf[ks] = *(const bf16x8*)(PROJ + (mb + tq) * PC + 1280 + hq * 64 + ks * 32 + quad * 8);
            const LAS bf16* Kb = Ks + (kt0 * 16 + l15) * 72 + quad * 8;
            const LAS bf16* Vb = Vt + l15 * 200 + kt0 * 16 + quad * 4;
            const float fd = (float)(l15 + 128 - quad * 4);
            f32x4 oacc[4]; float inv;
            if (t0 < 128) attn_ct<true>(Kb, Vb, qf, fd, quad * 4, l15, 128 - t0 - kt0 * 16, slope2, sink2, lane, oacc, inv);
            else attn_ct<false>(Kb, Vb, qf, fd, quad * 4, l15, 0, slope2, sink2, lane, oacc, inv);
            if (t < L) {
#pragma unroll
                for (int dt = 0; dt < 4; ++dt) st4bf(YC + (mb + t) * 512 + hq * 64 + dt * 16 + quad * 4, oacc[dt] * inv); }
        }
    }
}


#define XB_TMO      128
#define XB_XCNT(j)  (256  + 64 * (j))
#define XB_XSUB(j)  (1280 + 64 * (j))
#define XB_XGEN(j)  (2304 + 64 * (j))
#define XB_TOP      3328
#define XB_TOPGEN   3392
#define XCD_BAR_WORDS 3456
#define XB_SPIN_CAP (1u << 18)

__device__ __forceinline__ unsigned xb_ld(unsigned* p)              { return __hip_atomic_load(p, __ATOMIC_RELAXED, __HIP_MEMORY_SCOPE_AGENT); }
__device__ __forceinline__ unsigned xb_add(unsigned* p, unsigned v) { return __hip_atomic_fetch_add(p, v, __ATOMIC_RELAXED, __HIP_MEMORY_SCOPE_AGENT); }
__device__ __forceinline__ unsigned xb_xcc_id() { return (unsigned)__builtin_amdgcn_s_getreg((3 << 11) | 20) & 0xFu; }
#define XB_SPIN(cond, bar) do { unsigned _sp = 0; while (cond) { __builtin_amdgcn_s_sleep(1); \
    if ((++_sp & 255u) == 0u) { if (xb_ld(&(bar)[XB_TMO])) break; if (_sp > XB_SPIN_CAP) { atomicAdd(&(bar)[XB_TMO], 1u); break; } } } } while (0)

struct XcdBarrier {
    unsigned* bar; unsigned x;
    volatile LAS unsigned* st;
};

__device__ __forceinline__ XcdBarrier xcd_barrier_post(unsigned* bar, volatile LAS unsigned* st) {
    XcdBarrier b; b.bar = bar; b.x = xb_xcc_id(); b.st = st;
    if (threadIdx.x == 0) (void)xb_add(&bar[XB_XCNT(b.x)], 1u);
    return b;
}
__device__ __forceinline__ void xcd_barrier_complete(unsigned* bar, unsigned x, unsigned& nloc, unsigned& nx) {
    const unsigned G = gridDim.x * gridDim.y * gridDim.z;
    unsigned sum, cnt, mine, sp = 0u;
    for (;;) {
        sum = 0u; cnt = 0u; mine = 0u;
#pragma unroll
        for (unsigned j = 0; j < 16; ++j) { const unsigned c = xb_ld(&bar[XB_XCNT(j)]); sum += c; cnt += (c > 0u) ? 1u : 0u; mine = (j == x) ? c : mine; }
        if (sum == G) break;
        __builtin_amdgcn_s_sleep(1);
        if ((++sp & 255u) == 0u) { if (xb_ld(&bar[XB_TMO])) break; if (sp > XB_SPIN_CAP) { atomicAdd(&bar[XB_TMO], 1u); break; } }
    }
    nloc = mine > 0u ? mine : 1u; nx = cnt > 0u ? cnt : 1u;
}

__device__ __forceinline__ void xcd_barrier(const XcdBarrier& b) {
    asm volatile("s_waitcnt vmcnt(0)" ::: "memory");
    __syncthreads();
    if (threadIdx.x == 0) {
        unsigned* bar = b.bar;
        __builtin_amdgcn_s_waitcnt(0);
        unsigned nloc = b.st[0], nx = b.st[1];
        if (nloc == 0u) { xcd_barrier_complete(bar, b.x, nloc, nx); b.st[0] = nloc; b.st[1] = nx; }
        const unsigned old = xb_add(&bar[XB_XSUB(b.x)], 1u);
        const unsigned gen = old / nloc;
        if (old + 1u == (gen + 1u) * nloc) {
            __builtin_amdgcn_fence(__ATOMIC_RELEASE, "agent");
            asm volatile("s_waitcnt vmcnt(0)" ::: "memory");
            const unsigned og = xb_add(&bar[XB_TOP], 1u);
            const unsigned tg = og / nx;
            if (og + 1u == (tg + 1u) * nx) xb_add(&bar[XB_TOPGEN], 1u);
            else XB_SPIN(xb_ld(&bar[XB_TOPGEN]) == tg, bar);
            __builtin_amdgcn_fence(__ATOMIC_ACQUIRE, "agent");
            xb_add(&bar[XB_XGEN(b.x)], 1u);
            asm volatile("s_waitcnt vmcnt(0)" ::: "memory");
        } else {
            XB_SPIN(xb_ld(&bar[XB_XGEN(b.x)]) == gen, bar);
            __builtin_amdgcn_fence(__ATOMIC_ACQUIRE, "agent");
            asm volatile("s_waitcnt vmcnt(0)" ::: "memory");
        }
    }
    __syncthreads();
}

#ifndef REP_MASK
#define REP_MASK 0
#endif
#ifndef PMASK
#define PMASK 0xFFFF
#endif
#define EN(b) ((PMASK >> (b)) & 1)
__global__ void __launch_bounds__(512, 2) mega_fwd(Params p) {
    extern __shared__ __attribute__((aligned(16))) unsigned char lds_raw[];
    LAS unsigned char* lds = (LAS unsigned char*)lds_raw;
    XcdBarrier xbar; xbar.bar = nullptr; xbar.x = 0; xbar.st = nullptr;
    if (p.ph_hi - p.ph_lo > 1) {
        unsigned* barw = (unsigned*)(p.ws + WS_CTL + 65536);
        volatile LAS unsigned* MISC = (volatile LAS unsigned*)(lds + 131072 + 320);
        if (threadIdx.x < 64) MISC[threadIdx.x] = 0u;
        if (blockIdx.x == 0) for (int i = threadIdx.x; i < XCD_BAR_WORDS; i += 512) __hip_atomic_store(barw + i, 0u, __ATOMIC_RELAXED, __HIP_MEMORY_SCOPE_AGENT);
        __threadfence();
        cg::this_grid().sync();
        xbar = xcd_barrier_post(barw, MISC + 8);
    }
    for (int ph = p.ph_lo; ph < p.ph_hi; ++ph) {
        int tid = threadIdx.x; asm volatile("" : "+v"(tid));
        const int G = gridDim.x;
        unsigned char* ws = p.ws; asm volatile("" : "+s"(ws));
        bf16* Z = (bf16*)p.out;
        bf16* PROJ = (bf16*)(ws + WS_PROJ);
        unsigned char* wb = ws + WS_W;
        const int layer = ph / PER_LAYER, s = ph - layer * PER_LAYER;
        int nrep = 1;
        if (REP_MASK) {
            const int cls = (layer == DEPTH) ? 3 : (s == 5) ? 0 : (s == 1 || s == 3 || s == 11) ? 1 : (s == 2) ? 2 : (s == 0 || s == 10) ? 3 : (s == 6) ? 4 : 15;
            if ((REP_MASK >> cls) & 1) nrep = 2;
        }
        for (int rep = 0; rep < nrep; ++rep) {
        if (rep) __syncthreads();
        if (layer == DEPTH) {
            if (EN(0)) norm_phase<2>(p, INP(4), tid);
        } else if (s == 0) {
            if (EN(0)) { if (layer == 0) norm_phase<1>(p, INP(2), tid); else norm_phase<0>(p, INP(2) + layer * DM, tid); }
            if (EN(1)) convert_phase(p, layer, lds, tid);
        } else if (s == 10) {
            if (EN(0)) norm_phase<0>(p, INP(3) + layer * DM, tid);
        } else if (s == 2) {
            if (EN(2)) attn_phase(p, layer, lds, tid);
            if (EN(3)) prep1_phase(p, layer, tid);
        } else if (s == 4) {
            if (EN(4)) prep2_phase(p, layer, tid);
        } else if (s == 5) {
            if (EN(5)) scan_phase(p, layer, lds, tid);
        } else if (s == 6) {
            if (EN(6)) pool_phase(p, layer, lds, tid);
            if (EN(7) && rep == 0) post_phase(p, layer, tid);
        } else if (EN(8)) {
            const bf16* YB_ = (const bf16*)(ws + WS_Y);
            bf16* T3 = (bf16*)(ws + WS_SR);
            const int nsub = (s == 7) ? 4 : (s == 3 && layer > 0) ? 2 : 1;
            for (int sub = 0; sub < nsub; ++sub) {
                pg8::Gemm g; pg8::EpiAny E{};
                if (s == 1) { g = pg8::Gemm{Z, (const bf16*)(wb + W_IN), M, 3072, 1024}; E.kind = 0; E.perm = true; E.st = pg8::EpiStore{PROJ, PC}; }
                else if (s == 3 && sub == 0) { g = pg8::Gemm{YB_, (const bf16*)(wb + W_L), M, 768, 256}; E.kind = 0; E.perm = true; E.st = pg8::EpiStore{PROJ, PC}; }
                else if (s == 3) { g = pg8::Gemm{YB_ + (size_t)M * 256, (const bf16*)(wb + W_L) + (size_t)768 * 256, M, 256, 256}; E.kind = 0; E.perm = true; E.st = pg8::EpiStore{PROJ + 768, PC}; }
                else if (s == 7 && sub == 0) { g = pg8::Gemm{YB_, (const bf16*)(wb + W_BA), M, 1024, 256}; E.kind = 0; E.perm = true; E.st = pg8::EpiStore{PROJ, 1024}; }
                else if (s == 7 && sub == 1) { g = pg8::Gemm{YB_ + (size_t)M * 256, (const bf16*)(wb + W_BB), M, 1024, 256}; E.kind = 0; E.perm = true; E.st = pg8::EpiStore{PROJ + (size_t)M * 1024, 1024}; }
                else if (s == 7 && sub == 2) { g = pg8::Gemm{YB_ + (size_t)M * 512, (const bf16*)(wb + W_BC), M, 1024, 512}; E.kind = 0; E.perm = true; E.st = pg8::EpiStore{PROJ + (size_t)M * 2048, 1024}; }
                else if (s == 7) { g = pg8::Gemm{YB_ + (size_t)M * 1024, (const bf16*)(wb + W_BD), M, 1024, 256}; E.kind = 0; E.perm = true; E.st = pg8::EpiStore{T3, 1024}; }
                else if (s == 8) { g = pg8::Gemm{Z, (const bf16*)(wb + W_G), M, 4096, 1024}; E.kind = 1; E.perm = false;
                    E.gt = pg8::EpiGate4{PROJ, PROJ + (size_t)M * 1024, PROJ + (size_t)M * 2048, T3, PROJ}; }
                else if (s == 9) { g = pg8::Gemm{PROJ, (const bf16*)(wb + W_OUT), M, 1024, 1024}; E.kind = 2; E.perm = false; E.rs = pg8::EpiResid{(bf16*)(ws + WS_H)}; }
                else if (s == 12) { g = pg8::Gemm{PROJ, (const bf16*)(wb + W_DN), M, 1024, 2816}; E.kind = 2; E.perm = false; E.rs = pg8::EpiResid{(bf16*)(ws + WS_H)}; }
                else { g = pg8::Gemm{Z, (const bf16*)(wb + W_UP), M, 5632, 1024}; E.kind = 3; E.perm = false; E.sw = pg8::EpiSwiglu{PROJ}; }
                pg8::StaticOrder S; S.init(M, g.N, G, (int)((blockIdx.x + 64u * (unsigned)sub) % (unsigned)G));
                pg8::gemm_phase<pg8::EpiAny, pg8::StaticOrder, true, true>(lds, g, S, E);
            }
        }
        }
        if (ph + 1 < p.ph_hi) { xcd_barrier(xbar); if (REP_MASK & 32) xcd_barrier(xbar); }
    }
}

extern "C" void kernel_launch(void* const* d_in, const int* in_sizes, int n_in, void* d_out, int out_size, void* d_ws, size_t ws_size, hipStream_t stream) {
    static int grid = 0;
    if (grid == 0) {
        if (n_in != 29 || ws_size < WS_END) { fprintf(stderr, "kernel_launch: unexpected n_in %d or ws %zu (< %zu)\n", n_in, ws_size, (size_t)WS_END); grid = -1; return; }
        if (hipFuncSetAttribute((const void*)mega_fwd, hipFuncAttributeMaxDynamicSharedMemorySize, LDS_BYTES) != hipSuccess) { fprintf(stderr, "kernel_launch: hipFuncSetAttribute failed\n"); grid = -1; return; }
        int dev = 0, cus = 0, per_cu = 0;
        hipGetDevice(&dev); hipDeviceGetAttribute(&cus, hipDeviceAttributeMultiprocessorCount, dev);
        hipOccupancyMaxActiveBlocksPerMultiprocessor(&per_cu, (const void*)mega_fwd, 512, LDS_BYTES);
        (void)hipGetLastError();
        if (per_cu < 1) per_cu = 1;
        grid = cus > 0 ? cus : 256;
    }
    if (grid < 0) return;
    Params p{};
    for (int i = 0; i < 29; ++i) p.in[i] = (const float*)d_in[i];
    p.out = (float*)d_out; p.ws = (unsigned char*)d_ws;
#if SINGLE_LAUNCH
    p.ph_lo = 0; p.ph_hi = NPH;
    void* args[] = {&p};
    hipError_t e = hipLaunchCooperativeKernel((const void*)mega_fwd, dim3(grid), dim3(512), args, LDS_BYTES, stream);
    if (e != hipSuccess) fprintf(stderr, "cooperative launch failed: %s (grid %d)\n", hipGetErrorString(e), grid);
#else
    for (int ph = 0; ph < NPH; ++ph) { p.ph_lo = ph; p.ph_hi = ph + 1; hipLaunchKernelGGL(mega_fwd, dim3(grid), dim3(512), LDS_BYTES, stream, p); }
#endif
}
```
